# Optimizing an MI355X kernel written in HIP

```python
import math
import jax, jax.numpy as jnp
from jax import lax
import numpy as np


D_MODEL = 1024
BATCH = 8
SEQ = 4096
DEPTH = 4

CHUNK = 64
Q_BLOCK = 128
MEM_LEN = 256

MLA_HEADS = 8
MLA_NOPE = 64
MLA_ROPE = 32
MLA_V = 64
MLA_QK = MLA_NOPE + MLA_ROPE
Q_LORA = 384
KV_LORA = 256
ROPE_BASE = 10000.0

DIFF_HEADS = 4
DIFF_QK = 64
DIFF_V = 2 * DIFF_QK

MEM_HEADS = 4
MEM_HEAD_DIM = 128

BRANCH_W = 512
N_BRANCH = 3
D_FF = 4 * D_MODEL

T5_BUCKETS = 32
T5_MAX_DIST = 128

EPS = 1e-6
NEG = -1e30

SPLITS = [Q_LORA, KV_LORA, MLA_ROPE,
          DIFF_HEADS * 2 * DIFF_QK, DIFF_HEADS * 2 * DIFF_QK, DIFF_HEADS * DIFF_V,
          MEM_HEADS * MEM_HEAD_DIM, N_BRANCH * D_MODEL]
D_IN = sum(SPLITS)

kernel_name = 'hybrid_mla_diffattn_memxattn_gated_block'


def rmsnorm(x, g):
    x32 = x.astype(jnp.float32)
    y = x32 * lax.rsqrt(jnp.mean(x32 * x32, axis=-1, keepdims=True) + EPS)
    return (y * g.astype(jnp.float32)).astype(x.dtype)


def rope(x, positions):
    half = MLA_ROPE // 2
    inv = jnp.power(jnp.float32(ROPE_BASE), -jnp.arange(half, dtype=jnp.float32) / half)
    ang = positions.astype(jnp.float32)[..., None] * inv
    ang = ang.reshape(ang.shape[:2] + (1,) * (x.ndim - 3) + (half,))
    cos, sin = jnp.cos(ang), jnp.sin(ang)
    x32 = x.astype(jnp.float32)
    x1, x2 = x32[..., :half], x32[..., half:]
    out = jnp.concatenate([x1 * cos - x2 * sin, x2 * cos + x1 * sin], axis=-1)
    return out.astype(x.dtype)


def t5_bucket(rel):
    n = T5_BUCKETS // 2
    ret = jnp.where(rel > 0, n, 0)
    a = jnp.abs(rel)
    max_exact = n // 2
    af = jnp.maximum(a, 1).astype(jnp.float32)
    large = max_exact + (jnp.log(af / max_exact) / math.log(T5_MAX_DIST / max_exact)
                         * (n - max_exact)).astype(jnp.int32)
    large = jnp.minimum(large, n - 1)
    return ret + jnp.where(a < max_exact, a, large)


def to_blocks(t):
    b, s = t.shape[0], t.shape[1]
    t = t.reshape((b, s // Q_BLOCK, Q_BLOCK) + t.shape[2:])
    return jnp.moveaxis(t, 1, 0)


def from_blocks(t):
    t = jnp.moveaxis(t, 0, 1)
    return t.reshape((t.shape[0], t.shape[1] * t.shape[2]) + t.shape[3:])


def chunk_mask(blk, seq):
    q_chunk = (blk * Q_BLOCK + jnp.arange(Q_BLOCK)) // CHUNK
    k_chunk = jnp.arange(seq) // CHUNK
    return k_chunk[None, :] <= q_chunk[:, None]


def mla_attention(q, k, v):
    seq = q.shape[1]
    scale = MLA_QK ** -0.5

    def one(args):
        qb, blk = args
        s = jnp.einsum('bqhd,bkhd->bhqk', qb, k, preferred_element_type=jnp.float32) * scale
        s = jnp.where(chunk_mask(blk, seq)[None, None], s, NEG)
        p = jax.nn.softmax(s, axis=-1)
        return jnp.einsum('bhqk,bkhd->bqhd', p.astype(v.dtype), v)

    o = lax.map(one, (to_blocks(q), jnp.arange(seq // Q_BLOCK)))
    return from_blocks(o)


def diff_attention(q, k, v, positions, t5_table, lam):
    seq = q.shape[1]
    scale = DIFF_QK ** -0.5
    table = t5_table.astype(jnp.float32)

    def one(args):
        qb, pq, blk = args
        s = jnp.einsum('bqhcd,bkhcd->bhcqk', qb, k, preferred_element_type=jnp.float32) * scale
        rel = positions[:, None, :] - pq[:, :, None]
        bias = jnp.moveaxis(table[t5_bucket(rel)], -1, 1)
        s = s + bias[:, :, None]
        s = jnp.where(chunk_mask(blk, seq)[None, None, None], s, NEG)
        p = jax.nn.softmax(s, axis=-1)
        pd = p[:, :, 0] - lam * p[:, :, 1]
        return jnp.einsum('bhqk,bkhd->bqhd', pd.astype(v.dtype), v)

    o = lax.map(one, (to_blocks(q), to_blocks(positions), jnp.arange(seq // Q_BLOCK)))
    return from_blocks(o)


def cross_attention(q, km, vm):
    scale = MEM_HEAD_DIM ** -0.5
    s = jnp.einsum('bqhd,bmhd->bhqm', q, km, preferred_element_type=jnp.float32) * scale
    p = jax.nn.softmax(s, axis=-1)
    return jnp.einsum('bhqm,bmhd->bqhd', p.astype(vm.dtype), vm)


def setup_inputs(seed: int = 0) -> dict:
    key = jax.random.key(seed)
    ks = jax.random.split(key, 32)
    f32 = jnp.float32

    def dense(k, shape, fan_in, scale=1.0):
        return jax.random.normal(k, shape, f32) * (scale * fan_in ** -0.5)

    def gain(k, shape):
        return 1.0 + 0.02 * jax.random.normal(k, shape, f32)

    start = jax.random.randint(ks[2], (BATCH, 1), 0, 4096, dtype=jnp.int32)
    positions = start + jnp.arange(SEQ, dtype=jnp.int32)[None, :]
    return {
        'x': jax.random.normal(ks[0], (BATCH, SEQ, D_MODEL), f32),
        'mem': jax.random.normal(ks[1], (BATCH, MEM_LEN, D_MODEL), f32),
        'positions': positions,
        't5_table': 0.5 * jax.random.normal(ks[3], (T5_BUCKETS, DIFF_HEADS), f32),
        'g_mix': gain(ks[4], (DEPTH, D_MODEL)),
        'g_mem': gain(ks[5], (DEPTH, D_MODEL)),
        'w_in': dense(ks[6], (DEPTH, D_MODEL, D_IN), D_MODEL),
        'g_cq': gain(ks[7], (DEPTH, Q_LORA)),
        'w_uq': dense(ks[8], (DEPTH, Q_LORA, MLA_HEADS * MLA_QK), Q_LORA),
        'g_ckv': gain(ks[9], (DEPTH, KV_LORA)),
        'w_ukv': dense(ks[10], (DEPTH, KV_LORA, MLA_HEADS * (MLA_NOPE + MLA_V)), KV_LORA),
        'g_mla_q': gain(ks[11], (DEPTH, MLA_QK)),
        'g_mla_k': gain(ks[12], (DEPTH, MLA_QK)),
        'g_diff_q': gain(ks[13], (DEPTH, DIFF_QK)),
        'g_diff_k': gain(ks[14], (DEPTH, DIFF_QK)),
        'lam_q1': 0.1 * jax.random.normal(ks[15], (DEPTH, DIFF_QK), f32),
        'lam_k1': 0.1 * jax.random.normal(ks[16], (DEPTH, DIFF_QK), f32),
        'lam_q2': 0.1 * jax.random.normal(ks[17], (DEPTH, DIFF_QK), f32),
        'lam_k2': 0.1 * jax.random.normal(ks[18], (DEPTH, DIFF_QK), f32),
        'g_diff_out': gain(ks[19], (DEPTH, DIFF_V)),
        'w_mem_kv': dense(ks[20], (DEPTH, D_MODEL, 2 * MEM_HEADS * MEM_HEAD_DIM), D_MODEL),
        'g_mem_q': gain(ks[21], (DEPTH, MEM_HEAD_DIM)),
        'g_mem_k': gain(ks[22], (DEPTH, MEM_HEAD_DIM)),
        'w_branch': dense(ks[23], (DEPTH, N_BRANCH, BRANCH_W, D_MODEL), BRANCH_W),
        'w_out': dense(ks[24], (DEPTH, D_MODEL, D_MODEL), D_MODEL, 0.5),
        'g_mlp': gain(ks[25], (DEPTH, D_MODEL)),
        'w_ff1': dense(ks[26], (DEPTH, D_MODEL, D_FF), D_MODEL),
        'w_ff2': dense(ks[27], (DEPTH, D_FF, D_MODEL), D_FF, 0.5),
    }


def reference(x, mem, positions, t5_table, g_mix, g_mem, w_in, g_cq, w_uq, g_ckv, w_ukv,
              g_mla_q, g_mla_k, g_diff_q, g_diff_k, lam_q1, lam_k1, lam_q2, lam_k2,
              g_diff_out, w_mem_kv, g_mem_q, g_mem_k, w_branch, w_out, g_mlp, w_ff1, w_ff2):
    b, s, _ = x.shape
    m = mem.shape[1]
    split_points = np.cumsum(SPLITS)[:-1].tolist()
    for l in range(DEPTH):
        h = rmsnorm(x, g_mix[l])
        z = h @ w_in[l]
        c_q, c_kv, k_r, dq, dk, dv, mq, gl = jnp.split(z, split_points, axis=-1)

        q = (rmsnorm(c_q, g_cq[l]) @ w_uq[l]).reshape(b, s, MLA_HEADS, MLA_QK)
        kv = (rmsnorm(c_kv, g_ckv[l]) @ w_ukv[l]).reshape(b, s, MLA_HEADS, MLA_NOPE + MLA_V)
        k_nope, v_a = kv[..., :MLA_NOPE], kv[..., MLA_NOPE:]
        k = jnp.concatenate(
            [k_nope, jnp.broadcast_to(k_r[:, :, None, :], (b, s, MLA_HEADS, MLA_ROPE))], axis=-1)
        q = rmsnorm(q, g_mla_q[l])
        k = rmsnorm(k, g_mla_k[l])
        q = jnp.concatenate([q[..., :MLA_NOPE], rope(q[..., MLA_NOPE:], positions)], axis=-1)
        k = jnp.concatenate([k[..., :MLA_NOPE], rope(k[..., MLA_NOPE:], positions)], axis=-1)
        o_a = mla_attention(q, k, v_a).reshape(b, s, BRANCH_W)

        lam_init = 0.8 - 0.6 * math.exp(-0.3 * l)
        lam = (jnp.exp(jnp.sum(lam_q1[l].astype(jnp.float32) * lam_k1[l].astype(jnp.float32)))
               - jnp.exp(jnp.sum(lam_q2[l].astype(jnp.float32) * lam_k2[l].astype(jnp.float32)))
               + lam_init)
        dq = rmsnorm(dq.reshape(b, s, DIFF_HEADS, 2, DIFF_QK), g_diff_q[l])
        dk = rmsnorm(dk.reshape(b, s, DIFF_HEADS, 2, DIFF_QK), g_diff_k[l])
        dv = dv.reshape(b, s, DIFF_HEADS, DIFF_V)
        o_b = diff_attention(dq, dk, dv, positions, t5_table, lam)
        o_b = (rmsnorm(o_b, g_diff_out[l]) * (1.0 - lam_init)).reshape(b, s, BRANCH_W)

        hm = rmsnorm(mem, g_mem[l])
        mkv = (hm @ w_mem_kv[l]).reshape(b, m, 2, MEM_HEADS, MEM_HEAD_DIM)
        km = rmsnorm(mkv[:, :, 0], g_mem_k[l])
        vm = mkv[:, :, 1]
        mq = rmsnorm(mq.reshape(b, s, MEM_HEADS, MEM_HEAD_DIM), g_mem_q[l])
        o_c = cross_attention(mq, km, vm).reshape(b, s, BRANCH_W)

        gates = jax.nn.sigmoid(gl.reshape(b, s, N_BRANCH, D_MODEL))
        y = (gates[:, :, 0] * (o_a @ w_branch[l, 0])
             + gates[:, :, 1] * (o_b @ w_branch[l, 1])
             + gates[:, :, 2] * (o_c @ w_branch[l, 2]))
        x = x + y @ w_out[l]

        h2 = rmsnorm(x, g_mlp[l])
        x = x + jnp.square(jax.nn.relu(h2 @ w_ff1[l])) @ w_ff2[l]
    return x
```

```cpp
#include <hip/hip_runtime.h>
#include <hip/hip_cooperative_groups.h>
#include <cstdio>
namespace cg = cooperative_groups;

typedef unsigned short u16;
typedef __attribute__((ext_vector_type(8))) short bf16x8;
typedef __attribute__((ext_vector_type(16))) float f32x16;
typedef __bf16 bf2_t __attribute__((ext_vector_type(2)));
typedef float f2_t __attribute__((ext_vector_type(2)));

#define DI __device__ __forceinline__

#ifndef DUP_SUB
#define DUP_SUB -1
#endif
#ifndef SINGLE_LAUNCH
#define SINGLE_LAUNCH 1
#endif

constexpr int T_TOK = 32768;
constexpr int SEQ = 4096;
constexpr float LOG2E = 1.4426950408889634f;
constexpr float EPS = 1e-6f;
constexpr int NT = 512;
constexpr int LUT_OFF = 147456;
constexpr int LDS_BYTES = LUT_OFF + 1280;
constexpr int NSUB = 8;

constexpr size_t SZ_WIN = 2816ull * 1024 * 2, SZ_WG = 3072ull * 1024 * 2, SZ_WUQ = 768ull * 384 * 2, SZ_WUKV = 1024ull * 256 * 2,
                 SZ_WMEM = 1024ull * 1024 * 2, SZ_WBR = 3ull * 1024 * 512 * 2, SZ_WOUT = 1024ull * 1024 * 2, SZ_WFF = 4096ull * 1024 * 2;
constexpr size_t OFF_WIN = 0;
constexpr size_t OFF_WG = OFF_WIN + SZ_WIN;
constexpr size_t OFF_WUQ = OFF_WG + SZ_WG;
constexpr size_t OFF_WUKV = OFF_WUQ + SZ_WUQ;
constexpr size_t OFF_WMEM = OFF_WUKV + SZ_WUKV;
constexpr size_t OFF_WBR = OFF_WMEM + SZ_WMEM;
constexpr size_t OFF_WOUT = OFF_WBR + SZ_WBR;
constexpr size_t OFF_WFF1 = OFF_WOUT + SZ_WOUT;
constexpr size_t OFF_WFF2 = OFF_WFF1 + SZ_WFF;
constexpr size_t OFF_H = OFF_WFF2 + SZ_WFF;
constexpr size_t OFF_HM = OFF_H + (size_t)T_TOK * 1024 * 2;
constexpr size_t OFF_CS = OFF_HM + 2048ull * 1024 * 2;
constexpr size_t OFF_SSQ = OFF_CS + (size_t)T_TOK * 32 * 4;
constexpr size_t OFF_SSKV = OFF_SSQ + (size_t)T_TOK * 12;
constexpr size_t OFF_SSX2 = OFF_SSKV + (size_t)T_TOK * 8;
constexpr size_t OFF_SSX1 = OFF_SSX2 + (size_t)T_TOK * 16;
constexpr size_t OFF_MISC = OFF_SSX1 + (size_t)T_TOK * 32;
constexpr size_t OFF_R = OFF_MISC + 4096;
constexpr size_t R_CQ = OFF_R;
constexpr size_t R_CKV = R_CQ + (size_t)T_TOK * 384 * 2;
constexpr size_t R_KR = R_CKV + (size_t)T_TOK * 256 * 2;
constexpr size_t R_DQ = R_KR + (size_t)T_TOK * 32 * 4;
constexpr size_t R_DK = R_DQ + (size_t)T_TOK * 512 * 2;
constexpr size_t R_DV = R_DK + (size_t)T_TOK * 512 * 2;
constexpr size_t R_MQ = R_DV + (size_t)T_TOK * 512 * 2;
constexpr size_t R_Q = R_MQ + (size_t)T_TOK * 512 * 2;
constexpr size_t R_K = R_Q + (size_t)T_TOK * 768 * 2;
constexpr size_t R_V = R_K + (size_t)T_TOK * 768 * 2;
constexpr size_t R_KM = R_V + (size_t)T_TOK * 512 * 2;
constexpr size_t R_VM = R_KM + 2048ull * 512 * 2;
constexpr size_t R_OB = R_VM + 2048ull * 512 * 2;
constexpr size_t R_OC = R_OB + (size_t)T_TOK * 512 * 2;
constexpr size_t WS_END = R_OC + (size_t)T_TOK * 512 * 2;
constexpr size_t R_OA = R_CQ;
constexpr size_t R_Y = R_DQ;
constexpr size_t R_U = OFF_R;
static_assert(R_U + (size_t)T_TOK * 4096 * 2 <= WS_END, "u must fit in region");

struct Params {
  const float* x; const float* mem; const int* pos; const float* t5;
  const float* g_mix; const float* g_mem; const float* w_in; const float* g_cq; const float* w_uq; const float* g_ckv; const float* w_ukv;
  const float* g_mla_q; const float* g_mla_k; const float* g_diff_q; const float* g_diff_k;
  const float* lam_q1; const float* lam_k1; const float* lam_q2; const float* lam_k2; const float* g_diff_out;
  const float* w_mem_kv; const float* g_mem_q; const float* g_mem_k; const float* w_branch; const float* w_out; const float* g_mlp;
  const float* w_ff1; const float* w_ff2;
  float* out; char* ws;
  int ph_lo, ph_hi, flags, pad_;
};

DI int get_tid() { int t = threadIdx.x; asm volatile("" : "+v"(t)); return t; }
DI char* get_ws(const Params& p) { char* w = p.ws; asm volatile("" : "+s"(w)); return w; }
typedef unsigned u32x4 __attribute__((ext_vector_type(4)));
typedef const __attribute__((address_space(1))) u32x4* gu4p;
DI u32x4 ldg16(const void* p) { return *(gu4p)(p); }
DI unsigned pack2(float a, float b) { f2_t v = {a, b}; bf2_t r = __builtin_convertvector(v, bf2_t); return __builtin_bit_cast(unsigned, r); }
DI u16 tobf(float a) { return (u16)(pack2(a, 0.f) & 0xffffu); }
DI float xor32(float v) { return __shfl_xor(v, 32); }
DI float xsum32(float v) { const auto r = __builtin_amdgcn_permlane32_swap(__float_as_uint(v), __float_as_uint(v), false, false); return __uint_as_float(r[0]) + __uint_as_float(r[1]); }
DI float xmax32(float v) { const auto r = __builtin_amdgcn_permlane32_swap(__float_as_uint(v), __float_as_uint(v), false, false); return fmaxf(__uint_as_float(r[0]), __uint_as_float(r[1])); }
DI f32x16 mfma(bf16x8 a, bf16x8 b, f32x16 c) { return __builtin_amdgcn_mfma_f32_32x32x16_bf16(a, b, c, 0, 0, 0); }
DI float sumsq16(const f32x16& v) { float s = 0.f;
#pragma unroll
  for (int i = 0; i < 16; ++i) s += v[i] * v[i];
  return s; }
DI int perm16(int s) { return (s & ~12) | ((s & 4) << 1) | ((s & 8) >> 1); }
DI void st4(u16* dst, float a, float b, float c, float d) { uint2 o; o.x = pack2(a, b); o.y = pack2(c, d); *(uint2*)dst = o; }

DI void st_blk(u16* blk, int hh, const float* v) {
#pragma unroll
  for (int jp = 0; jp < 2; ++jp) {
    const unsigned ax = pack2(v[8 * jp + 0], v[8 * jp + 1]), ay = pack2(v[8 * jp + 2], v[8 * jp + 3]);
    const unsigned bx = pack2(v[8 * jp + 4], v[8 * jp + 5]), by = pack2(v[8 * jp + 6], v[8 * jp + 7]);
    const auto r1 = __builtin_amdgcn_permlane32_swap(ax, bx, false, false);
    const auto r2 = __builtin_amdgcn_permlane32_swap(ay, by, false, false);
    u32x4 o; o.x = r1[0]; o.y = r2[0]; o.z = r1[1]; o.w = r2[1];
    *(u32x4*)(blk + 16 * jp + 8 * hh) = o;
  }
}
DI void st_blk_plain(u16* blk, int hh, const f32x16& a) {
  float v[16];
#pragma unroll
  for (int i = 0; i < 16; ++i) v[i] = a[i];
  st_blk(blk, hh, v);
}
DI void st_blk_scaled(u16* blk, int hh, const f32x16& a, float rstd, const float* __restrict__ gblk) {
  float v[16];
#pragma unroll
  for (int j = 0; j < 4; ++j) {
    const float4 gv = *(const float4*)(gblk + 8 * j + 4 * hh);
    v[4 * j] = a[4 * j] * rstd * gv.x; v[4 * j + 1] = a[4 * j + 1] * rstd * gv.y; v[4 * j + 2] = a[4 * j + 2] * rstd * gv.z; v[4 * j + 3] = a[4 * j + 3] * rstd * gv.w;
  }
  st_blk(blk, hh, v);
}
DI void zero4(f32x16* acc) {
#pragma unroll
  for (int f = 0; f < 4; ++f)
#pragma unroll
    for (int i = 0; i < 16; ++i) acc[f][i] = 0.f;
}

constexpr int LROW = 144;
constexpr int GBUF = 512 * LROW;
constexpr int DROW = 128;
constexpr int DBUF = 512 * DROW;
typedef __attribute__((address_space(3))) void* lds_vp_t;
typedef const __attribute__((address_space(1))) void* glb_vp_t;
template <int NFB, int NTB>
DI void gemm_main(const u16* __restrict__ W, int ldw, const u16* __restrict__ X, int ldx, int nk, f32x16* acc, char* lds, int kws = 64, int kxs = 64) {
  constexpr int NAC = (2 * NFB * 32) / 64;
  constexpr int NBC = (4 * NTB * 32) / 64;
  constexpr int NPER = NAC + NBC;
  const int tid = get_tid(), lane = tid & 63, wave = tid >> 6, l32 = lane & 31, hh = lane >> 5;
  const int wf = wave >> 2, wt = wave & 3;
  const int crow = tid >> 3, q = tid & 7;
  const int gc = q ^ ((crow >> 1) & 7);
  const u16* wp = W + (size_t)crow * ldw + gc * 8;
  const u16* xp = X + (size_t)crow * ldx + gc * 8;
  char* lw = lds + tid * 16;
  const int xr = (l32 >> 1) & 7;
  const int abase = (wf * NFB * 32 + l32) * DROW;
  const int bbase = 256 * DROW + (wt * NTB * 32 + l32) * DROW;
#define DMA_ISSUE(STAGE, KTILE)                                                                                              \
  {                                                                                                                          \
    const size_t kw_ = (size_t)(KTILE) * kws, kx_ = (size_t)(KTILE) * kxs;                                                   \
    char* d_ = lw + (STAGE) * DBUF;                                                                                          \
    _Pragma("unroll") for (int i = 0; i < NAC; ++i)                                                                          \
      __builtin_amdgcn_global_load_lds((glb_vp_t)(wp + (size_t)(64 * i) * ldw + kw_), (lds_vp_t)(d_ + 64 * i * DROW), 16, 0, 0); \
    _Pragma("unroll") for (int i = 0; i < NBC; ++i)                                                                          \
      __builtin_amdgcn_global_load_lds((glb_vp_t)(xp + (size_t)(64 * i) * ldx + kx_), (lds_vp_t)(d_ + 256 * DROW + 64 * i * DROW), 16, 0, 0); \
  }
  __syncthreads();
  DMA_ISSUE(0, 0)
  asm volatile("s_waitcnt vmcnt(0)" ::: "memory");
  __builtin_amdgcn_s_barrier();
  for (int kt = 0; kt < nk; ++kt) {
    const char* cur = lds + (kt & 1) * DBUF;
    if (kt + 1 < nk) DMA_ISSUE((kt + 1) & 1, kt + 1)
#pragma unroll(NTB == 1 ? 2 : 4)
    for (int s = 0; s < 4; ++s) {
      const int ro = ((2 * s + hh) ^ xr) * 16;
      bf16x8 bfr[NTB];
#pragma unroll
      for (int tb = 0; tb < NTB; ++tb) bfr[tb] = *(const bf16x8*)(cur + bbase + tb * 32 * DROW + ro);
#pragma unroll
      for (int fb = 0; fb < NFB; ++fb) {
        const bf16x8 afr = *(const bf16x8*)(cur + abase + fb * 32 * DROW + ro);
#pragma unroll
        for (int tb = 0; tb < NTB; ++tb) acc[tb * NFB + fb] = mfma(afr, bfr[tb], acc[tb * NFB + fb]);
      }
    }
    asm volatile("s_waitcnt vmcnt(0) lgkmcnt(0)" ::: "memory");
    __builtin_amdgcn_s_barrier();
  }
#undef DMA_ISSUE
}

constexpr int EROW = 528;
constexpr int FROW = 1040;
DI void epi_put4(char* lds, int row, int col, float a, float b, float c, float d) {
  uint2 o; o.x = pack2(a, b); o.y = pack2(c, d);
  *(uint2*)(lds + row * EROW + col * 2) = o;
}
template <int ROWS>
DI void epi_flush(char* lds, u16* __restrict__ dst, size_t ld) {
  const int tid = get_tid();
  const int r0 = tid >> 5, ch = tid & 31;
  __syncthreads();
#pragma unroll 4
  for (int r = r0; r < ROWS; r += 16) {
    const u32x4 v = *(const u32x4*)(lds + r * EROW + ch * 16);
    *(u32x4*)(dst + (size_t)r * ld + ch * 8) = v;
  }
}

DI float rstd4(const float* ssp, int t) {
  return rsqrtf((ssp[t] + ssp[T_TOK + t] + ssp[2 * T_TOK + t] + ssp[3 * T_TOK + t]) * (1.f / 1024.f) + EPS);
}

DI void tile_map(int w, int tpx, int nft, int gf, int& tt, int& ft) {
  const int x = w & 7, j = w >> 3;
  const int pg = tpx * gf;
  int fg = j / pg; const int nfull = nft / gf; int gs = gf;
  if (fg >= nfull) { fg = nfull; gs = nft - gf * nfull; }
  const int r = j - fg * pg;
  const int per = 8 * gs;
  const int tg = r / per; const int r2 = r - tg * per;
  ft = fg * gf + (r2 >> 3);
  tt = x * tpx + tg * 8 + (r2 & 7);
}

DI void norm_rows8(const float* __restrict__ x, const float* __restrict__ g, u16* __restrict__ h, int item) {
  const int tid_ = get_tid(); const int lane = tid_ & 63, wave = tid_ >> 6;
  const size_t row = (size_t)item * 8 + wave;
  const float4* xr = (const float4*)(x + row * 1024);
  float4 v[4]; float ss = 0.f;
#pragma unroll
  for (int i = 0; i < 4; ++i) { v[i] = xr[lane + 64 * i]; ss += v[i].x * v[i].x + v[i].y * v[i].y + v[i].z * v[i].z + v[i].w * v[i].w; }
#pragma unroll
  for (int o = 32; o >= 1; o >>= 1) ss += __shfl_xor(ss, o);
  const float rstd = rsqrtf(ss * (1.f / 1024.f) + EPS);
#pragma unroll
  for (int i = 0; i < 4; ++i) {
    const float4 gv = ((const float4*)g)[lane + 64 * i];
    st4(h + row * 1024 + (size_t)(lane + 64 * i) * 4, v[i].x * rstd * gv.x, v[i].y * rstd * gv.y, v[i].z * rstd * gv.z, v[i].w * rstd * gv.w);
  }
}


DI void xb_rows8(const float* __restrict__ x, u16* __restrict__ xb, float* __restrict__ ssx, int item) {
  const int tid_ = get_tid(); const int lane = tid_ & 63, wave = tid_ >> 6;
  const size_t row = (size_t)item * 8 + wave;
  const float4* xr = (const float4*)(x + row * 1024);
  float ss = 0.f;
#pragma unroll
  for (int i = 0; i < 4; ++i) {
    const float4 v = xr[lane + 64 * i];
    ss += v.x * v.x + v.y * v.y + v.z * v.z + v.w * v.w;
    st4(xb + row * 1024 + (size_t)(lane + 64 * i) * 4, v.x, v.y, v.z, v.w);
  }
#pragma unroll
  for (int o = 32; o >= 1; o >>= 1) ss += __shfl_xor(ss, o);
  if (lane < 4) ssx[(size_t)lane * T_TOK + row] = (lane == 0) ? ss : 0.f;
}

DI void conv_tile(const float* __restrict__ src, int ld, int mode, int colbase, int f0, int k0, int K, u16* __restrict__ dst,
                  const float* __restrict__ gs, char* lds, bool blocked) {
  const int tid512 = get_tid();
  const int tid = tid512 & 255;
  float (*tile)[65] = (float (*)[65])(lds + (tid512 >> 8) * 16640);
  __syncthreads();
  {
    const int c4 = tid & 15, r0 = tid >> 4;
    const int fp = f0 + c4 * 4;
    int col;
    if (mode == 0) col = colbase + fp;
    else col = fp < 640 ? fp : (fp < 2688 ? fp + 32 : (fp < 2720 ? fp - 2688 + 640 : -1));
#pragma unroll
    for (int i = 0; i < 4; ++i) {
      const int k = r0 + 16 * i;
      float4 v = make_float4(0.f, 0.f, 0.f, 0.f);
      if (col >= 0) v = *(const float4*)(src + (size_t)(k0 + k) * ld + col);
      const float s = gs ? gs[k0 + k] : 1.f;
      tile[k][c4 * 4 + 0] = v.x * s; tile[k][c4 * 4 + 1] = v.y * s; tile[k][c4 * 4 + 2] = v.z * s; tile[k][c4 * 4 + 3] = v.w * s;
    }
  }
  __syncthreads();
  {
    const int f = tid >> 2, kq = (tid & 3) * 16;
    unsigned o[8];
#pragma unroll
    for (int j = 0; j < 8; ++j) o[j] = pack2(tile[kq + 2 * j][f], tile[kq + 2 * j + 1][f]);
    uint4* d = blocked ? (uint4*)(dst + ((size_t)((f0 >> 8) * (K >> 6) + (k0 >> 6)) * 256 + (f0 & 255) + f) * 64 + kq)
                       : (uint4*)(dst + (size_t)(f0 + f) * K + k0 + kq);
    d[0] = make_uint4(o[0], o[1], o[2], o[3]);
    d[1] = make_uint4(o[4], o[5], o[6], o[7]);
  }
}

constexpr int NCONV = 704 + 768 + 72 + 64 + 256 + 384 + 256 + 1024 + 1024;
DI void conv_item(const Params& p, int l, int item, char* lds) {
  char* ws = get_ws(p);
  int idx = item * 2 + (get_tid() >> 8);
  const float* src; int ld, mode = 0, colbase = 0, f0, k0, K; u16* dst; const float* gs = nullptr; bool blocked = false;
  if (idx < 704) { src = p.w_in + (size_t)l * 1024 * 5792; ld = 5792; mode = 1; f0 = (idx >> 4) * 64; k0 = (idx & 15) * 64; K = 1024; dst = (u16*)(ws + OFF_WIN); gs = p.g_mix + l * 1024; }
  else if ((idx -= 704) < 768) { src = p.w_in + (size_t)l * 1024 * 5792; ld = 5792; colbase = 2720; f0 = (idx >> 4) * 64; k0 = (idx & 15) * 64; K = 1024; dst = (u16*)(ws + OFF_WG); gs = p.g_mix + l * 1024; }
  else if ((idx -= 768) < 72) { src = p.w_uq + (size_t)l * 384 * 768; ld = 768; f0 = (idx / 6) * 64; k0 = (idx % 6) * 64; K = 384; dst = (u16*)(ws + OFF_WUQ); gs = p.g_cq + l * 384; }
  else if ((idx -= 72) < 64) { src = p.w_ukv + (size_t)l * 256 * 1024; ld = 1024; f0 = (idx >> 2) * 64; k0 = (idx & 3) * 64; K = 256; dst = (u16*)(ws + OFF_WUKV); gs = p.g_ckv + l * 256; }
  else if ((idx -= 64) < 256) { src = p.w_mem_kv + (size_t)l * 1024 * 1024; ld = 1024; f0 = (idx >> 4) * 64; k0 = (idx & 15) * 64; K = 1024; dst = (u16*)(ws + OFF_WMEM); }
  else if ((idx -= 256) < 384) { const int n = idx >> 7, r = idx & 127; src = p.w_branch + (size_t)(l * 3 + n) * 512 * 1024; ld = 1024; f0 = (r >> 3) * 64; k0 = (r & 7) * 64; K = 512; dst = (u16*)(ws + OFF_WBR) + (size_t)n * 1024 * 512; }
  else if ((idx -= 384) < 256) { src = p.w_out + (size_t)l * 1024 * 1024; ld = 1024; f0 = (idx >> 4) * 64; k0 = (idx & 15) * 64; K = 1024; dst = (u16*)(ws + OFF_WOUT); }
  else if ((idx -= 256) < 1024) { src = p.w_ff1 + (size_t)l * 1024 * 4096; ld = 4096; f0 = (idx >> 4) * 64; k0 = (idx & 15) * 64; K = 1024; dst = (u16*)(ws + OFF_WFF1); gs = p.g_mlp + l * 1024; }
  else { idx -= 1024; src = p.w_ff2 + (size_t)l * 4096 * 1024; ld = 1024; f0 = (idx >> 6) * 64; k0 = (idx & 63) * 64; K = 4096; dst = (u16*)(ws + OFF_WFF2); blocked = true; }
  conv_tile(src, ld, mode, colbase, f0, k0, K, dst, gs, lds, blocked);
}

DI void cs_item(const Params& p, int item) {
  const int e = item * NT + get_tid();
  const int t = e >> 4, i = e & 15;
  const float inv = __builtin_amdgcn_exp2f(-(float)i * 0.8304820237218405f);
  const float angf = (float)p.pos[t] * inv;
  const double rev = (double)angf * 0.15915494309189535;
  const float fr = (float)(rev - rint(rev));
  float2* cs = (float2*)(get_ws(p) + OFF_CS);
  cs[e] = make_float2(__builtin_amdgcn_cosf(fr), __builtin_amdgcn_sinf(fr));
}
DI void misc_item(const Params& p) {
  const int tid = get_tid();
  int* kpmax = (int*)(p.ws + OFF_MISC);
  for (int tile = tid; tile < 512; tile += NT) {
    int mx = p.pos[tile * 64];
    for (int k = 1; k < 64; ++k) mx = max(mx, p.pos[tile * 64 + k]);
    kpmax[tile] = mx;
  }
  if (tid < 4) {
    float d1 = 0.f, d2 = 0.f;
    for (int k = 0; k < 64; ++k) { d1 += p.lam_q1[tid * 64 + k] * p.lam_k1[tid * 64 + k]; d2 += p.lam_q2[tid * 64 + k] * p.lam_k2[tid * 64 + k]; }
    const float lam_init = 0.8f - 0.6f * expf(-0.3f * (float)tid);
    float* lam = (float*)(p.ws + OFF_MISC + 2048);
    lam[tid] = expf(d1) - expf(d2) + lam_init;
  }
}

DI void g1_epilogue(const Params& p, int l, int t, int ft, f32x16* acc, bool do_atomic) {
  char* ws = get_ws(p);
  const int tid_ = get_tid(); const int lane = tid_ & 63, wave = tid_ >> 6, l32 = lane & 31, hh = lane >> 5;
  const int b = t >> 12, s = t & 4095;
  if (ft < 5) {
    u16* dst; float* ssp;
    if (ft < 3) { dst = (u16*)(ws + R_CQ) + (size_t)t * 384 + ft * 128; ssp = (float*)(ws + OFF_SSQ) + (size_t)ft * T_TOK + t; }
    else { dst = (u16*)(ws + R_CKV) + (size_t)t * 256 + (ft - 3) * 128; ssp = (float*)(ws + OFF_SSKV) + (size_t)(ft - 3) * T_TOK + t; }
    float ss = 0.f;
#pragma unroll
    for (int fb = 0; fb < 4; ++fb) {
      ss += sumsq16(acc[fb]);
      st_blk_plain(dst + fb * 32, hh, acc[fb]);
    }
    ss = xsum32(ss);
    if (hh == 0) *ssp = ss;
  } else if (ft < 13) {
    const bool isq = ft < 9; const int head = isq ? ft - 5 : ft - 9;
    const float* g = (isq ? p.g_diff_q : p.g_diff_k) + l * 64;
    u16* base = (u16*)(ws + (isq ? R_DQ : R_DK));
    const float mul = isq ? 0.125f * LOG2E : 1.f;
#pragma unroll
    for (int c = 0; c < 2; ++c) {
      float ss = sumsq16(acc[2 * c]) + sumsq16(acc[2 * c + 1]);
      ss = xsum32(ss);
      const float rstd = rsqrtf(ss * (1.f / 64.f) + EPS) * mul;
      u16* dst = base + (((size_t)(b * 4 + head) * 2 + c) * 4096 + s) * 64;
#pragma unroll
      for (int fbb = 0; fbb < 2; ++fbb) st_blk_scaled(dst + fbb * 32, hh, acc[2 * c + fbb], rstd, g + fbb * 32);
    }
  } else if (ft < 17) {
    const int head = ft - 13;
    u16* dst = (u16*)(ws + R_DV) + ((size_t)(b * 4 + head) * 128) * 4096 + perm16(s);
#pragma unroll
    for (int fb = 0; fb < 4; ++fb)
#pragma unroll
      for (int i = 0; i < 16; ++i) {
        const int d = fb * 32 + 8 * (i >> 2) + 4 * hh + (i & 3);
        dst[(size_t)d * 4096] = tobf(acc[fb][i]);
      }
  } else if (ft < 21) {
    const int head = ft - 17;
    float ss = sumsq16(acc[0]) + sumsq16(acc[1]) + sumsq16(acc[2]) + sumsq16(acc[3]);
    ss = xsum32(ss);
    const float rstd = rsqrtf(ss * (1.f / 128.f) + EPS) * (0.08838834764831845f * LOG2E);
    const float* g = p.g_mem_q + l * 128;
    u16* dst = (u16*)(ws + R_MQ) + ((size_t)(b * 4 + head) * 4096 + s) * 128;
#pragma unroll
    for (int fb = 0; fb < 4; ++fb) st_blk_scaled(dst + fb * 32, hh, acc[fb], rstd, g + fb * 32);
  } else {
    float* dst = (float*)(ws + R_KR) + (size_t)t * 32;
#pragma unroll
    for (int j = 0; j < 4; ++j) *(float4*)(dst + 8 * j + 4 * hh) = make_float4(acc[0][4 * j], acc[0][4 * j + 1], acc[0][4 * j + 2], acc[0][4 * j + 3]);
  }
}

DI void memkv_epilogue(const Params& p, int l, int mt, int ft, f32x16* acc) {
  char* ws = get_ws(p);
  const int tid_ = get_tid(); const int lane = tid_ & 63, wave = tid_ >> 6, l32 = lane & 31, hh = lane >> 5;
  const int b = mt >> 8, m = mt & 255;
  if (ft < 4) {
    const int head = ft;
    float ss = sumsq16(acc[0]) + sumsq16(acc[1]) + sumsq16(acc[2]) + sumsq16(acc[3]);
    ss = xsum32(ss);
    const float rstd = rsqrtf(ss * (1.f / 128.f) + EPS);
    const float* g = p.g_mem_k + l * 128;
    u16* dst = (u16*)(ws + R_KM) + ((size_t)(b * 4 + head) * 256 + m) * 128;
#pragma unroll
    for (int fb = 0; fb < 4; ++fb) st_blk_scaled(dst + fb * 32, hh, acc[fb], rstd, g + fb * 32);
  } else {
    const int head = ft - 4;
    u16* dst = (u16*)(ws + R_VM) + ((size_t)(b * 4 + head) * 128) * 256 + perm16(m);
#pragma unroll
    for (int fb = 0; fb < 4; ++fb)
#pragma unroll
      for (int i = 0; i < 16; ++i) {
        const int d = fb * 32 + 8 * (i >> 2) + 4 * hh + (i & 3);
        dst[(size_t)d * 256] = tobf(acc[fb][i]);
      }
  }
}

DI void g2q_epilogue(const Params& p, int l, int t, int head, f32x16* acc) {
  char* ws = get_ws(p);
  const int tid_ = get_tid(); const int lane = tid_ & 63, wave = tid_ >> 6, l32 = lane & 31, hh = lane >> 5;
  const int b = t >> 12, s = t & 4095;
  const float* sq = (const float*)(ws + OFF_SSQ);
  const float rcq = rsqrtf((sq[t] + sq[T_TOK + t] + sq[2 * T_TOK + t]) * (1.f / 384.f) + EPS);
  float ss = 0.f;
#pragma unroll
  for (int fb = 0; fb < 3; ++fb)
#pragma unroll
    for (int i = 0; i < 16; ++i) { acc[fb][i] *= rcq; ss += acc[fb][i] * acc[fb][i]; }
  ss = xsum32(ss);
  const float qs = 0.10206207261596577f * LOG2E;
  const float rstd = rsqrtf(ss * (1.f / 96.f) + EPS) * qs;
  const float* g = p.g_mla_q + l * 96;
  u16* dst = (u16*)(ws + R_Q) + ((size_t)(b * 8 + head) * 4096 + s) * 96;
#pragma unroll
  for (int fb = 0; fb < 2; ++fb) st_blk_scaled(dst + fb * 32, hh, acc[fb], rstd, g + fb * 32);
  const float* cs = (const float*)(ws + OFF_CS) + (size_t)t * 32;
#pragma unroll
  for (int j = 0; j < 2; ++j) {
    const int i0 = 8 * j + 4 * hh;
    const float4 c01 = *(const float4*)(cs + 2 * i0), c23 = *(const float4*)(cs + 2 * i0 + 4);
    const float cc[4] = {c01.x, c01.z, c23.x, c23.z}, sn[4] = {c01.y, c01.w, c23.y, c23.w};
    const float4 g1 = *(const float4*)(g + 64 + i0), g2 = *(const float4*)(g + 80 + i0);
    const float g1a[4] = {g1.x, g1.y, g1.z, g1.w}, g2a[4] = {g2.x, g2.y, g2.z, g2.w};
    float o1[4], o2[4];
#pragma unroll
    for (int r = 0; r < 4; ++r) {
      const float x1 = acc[2][4 * j + r] * rstd * g1a[r], x2 = acc[2][4 * (j + 2) + r] * rstd * g2a[r];
      o1[r] = x1 * cc[r] - x2 * sn[r]; o2[r] = x2 * cc[r] + x1 * sn[r];
    }
    st4(dst + 64 + i0, o1[0], o1[1], o1[2], o1[3]);
    st4(dst + 80 + i0, o2[0], o2[1], o2[2], o2[3]);
  }
}

DI void g2kv_epilogue(const Params& p, int l, int t, int head, f32x16* acc) {
  char* ws = get_ws(p);
  const int tid_ = get_tid(); const int lane = tid_ & 63, wave = tid_ >> 6, l32 = lane & 31, hh = lane >> 5;
  const int b = t >> 12, s = t & 4095;
  const float* skv = (const float*)(ws + OFF_SSKV);
  const float rckv = rsqrtf((skv[t] + skv[T_TOK + t]) * (1.f / 256.f) + EPS);
  float ss = 0.f;
#pragma unroll
  for (int fb = 0; fb < 4; ++fb)
#pragma unroll
    for (int i = 0; i < 16; ++i) acc[fb][i] *= rckv;
  ss = sumsq16(acc[0]) + sumsq16(acc[1]);
  const float* krp = (const float*)(ws + R_KR) + (size_t)t * 32;
  float kr[16];
#pragma unroll
  for (int j = 0; j < 4; ++j) {
    const float4 v = *(const float4*)(krp + 8 * j + 4 * hh);
    kr[4 * j] = v.x; kr[4 * j + 1] = v.y; kr[4 * j + 2] = v.z; kr[4 * j + 3] = v.w;
    ss += v.x * v.x + v.y * v.y + v.z * v.z + v.w * v.w;
  }
  ss = xsum32(ss);
  const float rstd = rsqrtf(ss * (1.f / 96.f) + EPS);
  const float* g = p.g_mla_k + l * 96;
  u16* dst = (u16*)(ws + R_K) + ((size_t)(b * 8 + head) * 4096 + s) * 96;
#pragma unroll
  for (int fb = 0; fb < 2; ++fb)
#pragma unroll
    for (int j = 0; j < 4; ++j) {
      const int d = fb * 32 + 8 * j + 4 * hh;
      const float4 gv = *(const float4*)(g + d);
      st4(dst + d, acc[fb][4 * j] * rstd * gv.x, acc[fb][4 * j + 1] * rstd * gv.y, acc[fb][4 * j + 2] * rstd * gv.z, acc[fb][4 * j + 3] * rstd * gv.w);
    }
  const float* cs = (const float*)(ws + OFF_CS) + (size_t)t * 32;
#pragma unroll
  for (int j = 0; j < 2; ++j) {
    const int i0 = 8 * j + 4 * hh;
    const float4 c01 = *(const float4*)(cs + 2 * i0), c23 = *(const float4*)(cs + 2 * i0 + 4);
    const float cc[4] = {c01.x, c01.z, c23.x, c23.z}, sn[4] = {c01.y, c01.w, c23.y, c23.w};
    const float4 g1 = *(const float4*)(g + 64 + i0), g2 = *(const float4*)(g + 80 + i0);
    const float g1a[4] = {g1.x, g1.y, g1.z, g1.w}, g2a[4] = {g2.x, g2.y, g2.z, g2.w};
    float o1[4], o2[4];
#pragma unroll
    for (int r = 0; r < 4; ++r) {
      const float x1 = kr[4 * j + r] * rstd * g1a[r], x2 = kr[4 * (j + 2) + r] * rstd * g2a[r];
      o1[r] = x1 * cc[r] - x2 * sn[r]; o2[r] = x2 * cc[r] + x1 * sn[r];
    }
    st4(dst + 64 + i0, o1[0], o1[1], o1[2], o1[3]);
    st4(dst + 80 + i0, o2[0], o2[1], o2[2], o2[3]);
  }
  u16* vdst = (u16*)(ws + R_V) + ((size_t)(b * 8 + head) * 64) * 4096 + perm16(s);
#pragma unroll
  for (int fb = 2; fb < 4; ++fb)
#pragma unroll
    for (int i = 0; i < 16; ++i) {
      const int d = (fb - 2) * 32 + 8 * (i >> 2) + 4 * hh + (i & 3);
      vdst[(size_t)d * 4096] = tobf(acc[fb][i]);
    }
}

template <int DQK, int DV, bool BIAS>
DI void attn_tile(const char* cur, const bf16x8* qf, f32x16* o, float& m, float& lsum, int kt, int l32, int hh,
                  const int* __restrict__ posb, int qpos, int qmin, const int* __restrict__ kpmax, const float* lut) {
  constexpr int KROW = DQK * 2 + 16, VROW = 144, KB = 64 * KROW;
      f32x16 s0, s1;
#pragma unroll
      for (int i = 0; i < 16; ++i) { s0[i] = 0.f; s1[i] = 0.f; }
#pragma unroll
      for (int st = 0; st < DQK / 16; ++st) {
        const bf16x8 a0 = *(const bf16x8*)(cur + l32 * KROW + st * 32 + hh * 16);
        const bf16x8 a1 = *(const bf16x8*)(cur + (32 + l32) * KROW + st * 32 + hh * 16);
        s0 = mfma(a0, qf[st], s0);
        s1 = mfma(a1, qf[st], s1);
      }
      float cb = 0.f;
      if (BIAS) {
        const int kmx = kpmax[kt];
        if (kmx - qmin <= -128) {
          cb = lut[0];
        } else {
#pragma unroll
          for (int j = 0; j < 4; ++j) {
            const int4 k0 = *(const int4*)(posb + kt * 64 + 8 * j + 4 * hh);
            const int4 k1 = *(const int4*)(posb + kt * 64 + 32 + 8 * j + 4 * hh);
            const int ka[4] = {k0.x, k0.y, k0.z, k0.w}, kb[4] = {k1.x, k1.y, k1.z, k1.w};
#pragma unroll
            for (int r = 0; r < 4; ++r) {
              s0[4 * j + r] += lut[min(max(ka[r] - qpos, -128), 128) + 128];
              s1[4 * j + r] += lut[min(max(kb[r] - qpos, -128), 128) + 128];
            }
          }
        }
      }
      float mx = s0[0];
#pragma unroll
      for (int i = 1; i < 16; ++i) mx = fmaxf(mx, s0[i]);
#pragma unroll
      for (int i = 0; i < 16; ++i) mx = fmaxf(mx, s1[i]);
      mx = xmax32(mx) + cb;
      if (__any(mx > m + 8.f)) {
        const float mnew = fmaxf(m, mx);
        const float alpha = __builtin_amdgcn_exp2f(m - mnew);
        m = mnew;
        lsum *= alpha;
#pragma unroll
        for (int vb = 0; vb < DV / 32; ++vb)
#pragma unroll
          for (int i = 0; i < 16; ++i) o[vb][i] *= alpha;
      }
      const float sh = m - cb;
      float rs = 0.f;
#pragma unroll
      for (int i = 0; i < 16; ++i) { s0[i] = __builtin_amdgcn_exp2f(s0[i] - sh); rs += s0[i]; }
#pragma unroll
      for (int i = 0; i < 16; ++i) { s1[i] = __builtin_amdgcn_exp2f(s1[i] - sh); rs += s1[i]; }
      lsum += rs;
      bf16x8 pf[4];
#pragma unroll
      for (int ks = 0; ks < 4; ++ks) {
        const f32x16& sv = (ks < 2) ? s0 : s1;
        const int b0 = (ks & 1) * 8;
        uint4 u;
        u.x = pack2(sv[b0 + 0], sv[b0 + 1]); u.y = pack2(sv[b0 + 2], sv[b0 + 3]);
        u.z = pack2(sv[b0 + 4], sv[b0 + 5]); u.w = pack2(sv[b0 + 6], sv[b0 + 7]);
        pf[ks] = __builtin_bit_cast(bf16x8, u);
      }
#pragma unroll
      for (int vb = 0; vb < DV / 32; ++vb)
#pragma unroll
        for (int ks = 0; ks < 4; ++ks) {
          const bf16x8 a = *(const bf16x8*)(cur + KB + (vb * 32 + l32) * VROW + ks * 32 + hh * 16);
          o[vb] = mfma(a, pf[ks], o[vb]);
        }
    }

template <int DQK, int DV, bool BIAS>
DI void attn_ring(const bf16x8* qf, const u16* __restrict__ Kg, const u16* __restrict__ Vg, int ldv, int nt_wg, int nt_wave,
                  f32x16* o, char* lds, const int* __restrict__ posb, int qpos, int qmin, const int* __restrict__ kpmax, const float* lut) {
  constexpr int KROW = DQK * 2 + 16, VROW = 144;
  constexpr int KB = 64 * KROW, VB = DV * VROW, STAGE = KB + VB;
  constexpr int CPR = DQK / 8;
  constexpr int KCH = 64 * CPR;
  constexpr int NKC = (KCH + NT - 1) / NT;
  constexpr int NVC = DV * 8 / NT;
  static_assert(4 * STAGE <= LUT_OFF, "lds");
  const int tid = get_tid(), lane = tid & 63, l32 = lane & 31, hh = lane >> 5;
  int koff[NKC], kch[NKC];
#pragma unroll
  for (int i = 0; i < NKC; ++i) { const int c = min(tid + NT * i, KCH - 1); kch[i] = c * 8; koff[i] = (c / CPR) * KROW + (c % CPR) * 16; }
  const int vrow = tid >> 3, vcol = tid & 7;
  float m = -INFINITY, lsum = 0.f;
#pragma unroll
  for (int vb = 0; vb < DV / 32; ++vb)
#pragma unroll
    for (int i = 0; i < 16; ++i) o[vb][i] = 0.f;
  u32x4 rk[2][NKC], rv[2][NVC];
  const int last = nt_wg - 1;
#define RING_LOAD(T0)                                                                                                     \
  _Pragma("unroll") for (int h_ = 0; h_ < 2; ++h_) {                                                                      \
    const int t_ = min((T0) + h_, last);                                                                                  \
    _Pragma("unroll") for (int i = 0; i < NKC; ++i) rk[h_][i] = ldg16(Kg + (size_t)t_ * 64 * DQK + kch[i]);               \
    _Pragma("unroll") for (int i = 0; i < NVC; ++i) rv[h_][i] = ldg16(Vg + (size_t)(vrow + 64 * i) * ldv + t_ * 64 + vcol * 8); \
  }
#define RING_STORE(DS)                                                                                                    \
  _Pragma("unroll") for (int h_ = 0; h_ < 2; ++h_) {                                                                      \
    char* d_ = lds + ((DS) * 2 + h_) * STAGE;                                                                             \
    _Pragma("unroll") for (int i = 0; i < NKC; ++i) *(u32x4*)(d_ + koff[i]) = rk[h_][i];                                  \
    _Pragma("unroll") for (int i = 0; i < NVC; ++i) *(u32x4*)(d_ + KB + (vrow + 64 * i) * VROW + vcol * 16) = rv[h_][i];  \
  }
  __syncthreads();
  RING_LOAD(0)
  RING_STORE(0)
  RING_LOAD(2)
  __syncthreads();
  for (int j = 0; 2 * j < nt_wg; ++j) {
    RING_STORE((j + 1) & 1)
    RING_LOAD(2 * j + 4)
    __builtin_amdgcn_sched_barrier(0);
    const char* st = lds + (j & 1) * 2 * STAGE;
#pragma unroll 1
    for (int h2 = 0; h2 < 2; ++h2) {
      const int kt = 2 * j + h2;
      if (kt < nt_wave) attn_tile<DQK, DV, BIAS>(st + h2 * STAGE, qf, o, m, lsum, kt, l32, hh, posb, qpos, qmin, kpmax, lut);
    }
    __syncthreads();
  }
#undef RING_STORE
#undef RING_LOAD
  const float lt = xsum32(lsum);
  const float inv = 1.f / lt;
#pragma unroll
  for (int vb = 0; vb < DV / 32; ++vb)
#pragma unroll
    for (int i = 0; i < 16; ++i) o[vb][i] *= inv;
}

template <int DQK, int DV, bool BIAS, bool PF>
DI void attn_loop(const bf16x8* qf, const u16* __restrict__ Kg, const u16* __restrict__ Vg, int ldv, int nt_wg, int nt_wave,
                  f32x16* o, char* lds, const int* __restrict__ posb, int qpos, int qmin, const int* __restrict__ kpmax, const float* lut) {
  constexpr int KROW = DQK * 2 + 16, VROW = 144;
  constexpr int KB = 64 * KROW, VB = DV * VROW, STAGE = KB + VB;
  constexpr int CPR = DQK / 8;
  constexpr int KCH = 64 * CPR;
  constexpr int NKC = (KCH + NT - 1) / NT;
  constexpr int NVC = DV * 8 / NT;
  static_assert(2 * STAGE <= LUT_OFF, "lds");
  const int tid = get_tid(), lane = tid & 63, l32 = lane & 31, hh = lane >> 5;
  int koff[NKC], kch[NKC];
#pragma unroll
  for (int i = 0; i < NKC; ++i) { const int c = min(tid + NT * i, KCH - 1); kch[i] = c * 8; koff[i] = (c / CPR) * KROW + (c % CPR) * 16; }
  const int vrow = tid >> 3, vcol = tid & 7;
  float m = -INFINITY, lsum = 0.f;
#pragma unroll
  for (int vb = 0; vb < DV / 32; ++vb)
#pragma unroll
    for (int i = 0; i < 16; ++i) o[vb][i] = 0.f;
  u32x4 rk[NKC], rv[NVC];
  if (PF) {
    __syncthreads();
#pragma unroll
    for (int i = 0; i < NKC; ++i) rk[i] = ldg16(Kg + kch[i]);
#pragma unroll
    for (int i = 0; i < NVC; ++i) rv[i] = ldg16(Vg + (size_t)(vrow + 64 * i) * ldv + vcol * 8);
#pragma unroll
    for (int i = 0; i < NKC; ++i) *(u32x4*)(lds + koff[i]) = rk[i];
#pragma unroll
    for (int i = 0; i < NVC; ++i) *(u32x4*)(lds + KB + (vrow + 64 * i) * VROW + vcol * 16) = rv[i];
    __syncthreads();
  }
  for (int kt = 0; kt < nt_wg; ++kt) {
    const char* cur = PF ? lds + (kt & 1) * STAGE : lds;
    const bool more = (kt + 1) < nt_wg;
    if (PF) {
      const int ktn = more ? kt + 1 : kt;
#pragma unroll
      for (int i = 0; i < NKC; ++i) rk[i] = ldg16(Kg + (size_t)ktn * 64 * DQK + kch[i]);
#pragma unroll
      for (int i = 0; i < NVC; ++i) rv[i] = ldg16(Vg + (size_t)(vrow + 64 * i) * ldv + ktn * 64 + vcol * 8);
      __builtin_amdgcn_sched_barrier(0);
    } else {
      __syncthreads();
#pragma unroll
      for (int i = 0; i < NKC; ++i) rk[i] = ldg16(Kg + (size_t)kt * 64 * DQK + kch[i]);
#pragma unroll
      for (int i = 0; i < NVC; ++i) rv[i] = ldg16(Vg + (size_t)(vrow + 64 * i) * ldv + kt * 64 + vcol * 8);
#pragma unroll
      for (int i = 0; i < NKC; ++i) *(u32x4*)(lds + koff[i]) = rk[i];
#pragma unroll
      for (int i = 0; i < NVC; ++i) *(u32x4*)(lds + KB + (vrow + 64 * i) * VROW + vcol * 16) = rv[i];
      __syncthreads();
    }
    if (kt < nt_wave) {
      f32x16 s0, s1;
#pragma unroll
      for (int i = 0; i < 16; ++i) { s0[i] = 0.f; s1[i] = 0.f; }
#pragma unroll
      for (int st = 0; st < DQK / 16; ++st) {
        const bf16x8 a0 = *(const bf16x8*)(cur + l32 * KROW + st * 32 + hh * 16);
        const bf16x8 a1 = *(const bf16x8*)(cur + (32 + l32) * KROW + st * 32 + hh * 16);
        s0 = mfma(a0, qf[st], s0);
        s1 = mfma(a1, qf[st], s1);
      }
      float cb = 0.f;
      if (BIAS) {
        const int kmx = kpmax[kt];
        if (kmx - qmin <= -128) {
          cb = lut[0];
        } else {
#pragma unroll
          for (int j = 0; j < 4; ++j) {
            const int4 k0 = *(const int4*)(posb + kt * 64 + 8 * j + 4 * hh);
            const int4 k1 = *(const int4*)(posb + kt * 64 + 32 + 8 * j + 4 * hh);
            const int ka[4] = {k0.x, k0.y, k0.z, k0.w}, kb[4] = {k1.x, k1.y, k1.z, k1.w};
#pragma unroll
            for (int r = 0; r < 4; ++r) {
              s0[4 * j + r] += lut[min(max(ka[r] - qpos, -128), 128) + 128];
              s1[4 * j + r] += lut[min(max(kb[r] - qpos, -128), 128) + 128];
            }
          }
        }
      }
      float mx = s0[0];
#pragma unroll
      for (int i = 1; i < 16; ++i) mx = fmaxf(mx, s0[i]);
#pragma unroll
      for (int i = 0; i < 16; ++i) mx = fmaxf(mx, s1[i]);
      mx = xmax32(mx) + cb;
      if (__any(mx > m + 8.f)) {
        const float mnew = fmaxf(m, mx);
        const float alpha = __builtin_amdgcn_exp2f(m - mnew);
        m = mnew;
        lsum *= alpha;
#pragma unroll
        for (int vb = 0; vb < DV / 32; ++vb)
#pragma unroll
          for (int i = 0; i < 16; ++i) o[vb][i] *= alpha;
      }
      const float sh = m - cb;
      float rs = 0.f;
#pragma unroll
      for (int i = 0; i < 16; ++i) { s0[i] = __builtin_amdgcn_exp2f(s0[i] - sh); rs += s0[i]; }
#pragma unroll
      for (int i = 0; i < 16; ++i) { s1[i] = __builtin_amdgcn_exp2f(s1[i] - sh); rs += s1[i]; }
      lsum += rs;
      bf16x8 pf[4];
#pragma unroll
      for (int ks = 0; ks < 4; ++ks) {
        const f32x16& sv = (ks < 2) ? s0 : s1;
        const int b0 = (ks & 1) * 8;
        uint4 u;
        u.x = pack2(sv[b0 + 0], sv[b0 + 1]); u.y = pack2(sv[b0 + 2], sv[b0 + 3]);
        u.z = pack2(sv[b0 + 4], sv[b0 + 5]); u.w = pack2(sv[b0 + 6], sv[b0 + 7]);
        pf[ks] = __builtin_bit_cast(bf16x8, u);
      }
#pragma unroll
      for (int vb = 0; vb < DV / 32; ++vb)
#pragma unroll
        for (int ks = 0; ks < 4; ++ks) {
          const bf16x8 a = *(const bf16x8*)(cur + KB + (vb * 32 + l32) * VROW + ks * 32 + hh * 16);
          o[vb] = mfma(a, pf[ks], o[vb]);
        }
    }
    if (PF) {
      __builtin_amdgcn_sched_barrier(0);
      {
        char* nxt = lds + ((kt + 1) & 1) * STAGE;
#pragma unroll
        for (int i = 0; i < NKC; ++i) *(u32x4*)(nxt + koff[i]) = rk[i];
#pragma unroll
        for (int i = 0; i < NVC; ++i) *(u32x4*)(nxt + KB + (vrow + 64 * i) * VROW + vcol * 16) = rv[i];
      }
      __syncthreads();
    }
  }
  const float lt = xsum32(lsum);
  const float inv = 1.f / lt;
#pragma unroll
  for (int vb = 0; vb < DV / 32; ++vb)
#pragma unroll
    for (int i = 0; i < 16; ++i) o[vb][i] *= inv;
}

DI void mla_item(const Params& p, int b, int h, int qb, char* lds) {
  char* ws = get_ws(p);
  const int tid_ = get_tid(); const int lane = tid_ & 63, wave = tid_ >> 6, l32 = lane & 31, hh = lane >> 5;
  const int s = qb * 256 + wave * 32 + l32; const int t = b * 4096 + s;
  const u16* qp = (const u16*)(ws + R_Q) + ((size_t)(b * 8 + h) * 4096 + s) * 96;
  bf16x8 qf[6];
#pragma unroll
  for (int st = 0; st < 6; ++st) qf[st] = *(const bf16x8*)(qp + st * 16 + hh * 8);
  f32x16 o[2];
  attn_ring<96, 64, false>(qf, (const u16*)(ws + R_K) + (size_t)(b * 8 + h) * 4096 * 96, (const u16*)(ws + R_V) + (size_t)(b * 8 + h) * 64 * 4096,
                           4096, 4 * qb + 4, 4 * qb + 1 + (wave >> 1), o, lds, nullptr, 0, 0, nullptr, nullptr);
  u16* dst = (u16*)(ws + R_OA) + (size_t)t * 512 + h * 64;
#pragma unroll
  for (int vb = 0; vb < 2; ++vb) st_blk_plain(dst + vb * 32, hh, o[vb]);
}

DI void cross_item(const Params& p, int b, int h, int qb, char* lds) {
  char* ws = get_ws(p);
  const int tid_ = get_tid(); const int lane = tid_ & 63, wave = tid_ >> 6, l32 = lane & 31, hh = lane >> 5;
  const int s = qb * 256 + wave * 32 + l32; const int t = b * 4096 + s;
  const u16* qp = (const u16*)(ws + R_MQ) + ((size_t)(b * 4 + h) * 4096 + s) * 128;
  bf16x8 qf[8];
#pragma unroll
  for (int st = 0; st < 8; ++st) qf[st] = *(const bf16x8*)(qp + st * 16 + hh * 8);
  f32x16 o[4];
  attn_loop<128, 128, false, false>(qf, (const u16*)(ws + R_KM) + (size_t)(b * 4 + h) * 256 * 128, (const u16*)(ws + R_VM) + (size_t)(b * 4 + h) * 128 * 256,
                             256, 4, 4, o, lds, nullptr, 0, 0, nullptr, nullptr);
  u16* dst = (u16*)(ws + R_OC) + (size_t)t * 512 + h * 128;
#pragma unroll
  for (int vb = 0; vb < 4; ++vb) st_blk_plain(dst + vb * 32, hh, o[vb]);
}

DI void diff_item(const Params& p, int l, int b, int h, int qb, char* lds) {
  char* ws = get_ws(p);
  const int tid = get_tid(), lane = tid & 63, wave = tid >> 6, l32 = lane & 31, hh = lane >> 5;
  float* lut = (float*)(lds + LUT_OFF);
  __syncthreads();
  for (int idx = tid; idx < 257; idx += NT) {
    const int rel = idx - 128; const int a = rel < 0 ? -rel : rel;
    int v;
    if (a < 8) v = a;
    else { const float af = (float)a; v = min(8 + (int)(logf(af / 8.f) / 2.772588722239781f * 8.f), 15); }
    const int bucket = (rel > 0 ? 16 : 0) + v;
    lut[idx] = p.t5[bucket * 4 + h] * LOG2E;
  }
  const int s = qb * 256 + wave * 32 + l32; const int t = b * 4096 + s;
  const int qpos = p.pos[t];
  int qmin = qpos;
#pragma unroll
  for (int o = 16; o >= 1; o >>= 1) qmin = min(qmin, __shfl_xor(qmin, o));
  const float lam = ((const float*)(ws + OFF_MISC + 2048))[l];
  const float lam_init = 0.8f - 0.6f * expf(-0.3f * (float)l);
  const int* kpmax = (const int*)(ws + OFF_MISC) + b * 64;
  const int* posb = p.pos + b * 4096;
  const u16* vg = (const u16*)(ws + R_DV) + (size_t)(b * 4 + h) * 128 * 4096;
  f32x16 o[4];
  u16* dst = (u16*)(ws + R_OB) + (size_t)t * 512 + h * 128;
#pragma unroll
  for (int c = 0; c < 2; ++c) {
    const u16* qp = (const u16*)(ws + R_DQ) + (((size_t)(b * 4 + h) * 2 + c) * 4096 + s) * 64;
    bf16x8 qf[4];
#pragma unroll
    for (int st = 0; st < 4; ++st) qf[st] = *(const bf16x8*)(qp + st * 16 + hh * 8);
    attn_ring<64, 128, true>(qf, (const u16*)(ws + R_DK) + ((size_t)(b * 4 + h) * 2 + c) * 4096 * 64, vg, 4096, 4 * qb + 4, 4 * qb + 1 + (wave >> 1),
                             o, lds, posb, qpos, qmin, kpmax, lut);
    if (c == 0) {
#pragma unroll
      for (int vb = 0; vb < 4; ++vb)
#pragma unroll
        for (int j = 0; j < 4; ++j) st4(dst + vb * 32 + 8 * j + 4 * hh, o[vb][4 * j], o[vb][4 * j + 1], o[vb][4 * j + 2], o[vb][4 * j + 3]);
    }
  }
  float ss = 0.f;
#pragma unroll
  for (int vb = 0; vb < 4; ++vb)
#pragma unroll
    for (int j = 0; j < 4; ++j) {
      const uint2 pk = *(const uint2*)(dst + vb * 32 + 8 * j + 4 * hh);
      const float o0v[4] = {__uint_as_float(pk.x << 16), __uint_as_float(pk.x & 0xffff0000u), __uint_as_float(pk.y << 16), __uint_as_float(pk.y & 0xffff0000u)};
#pragma unroll
      for (int r = 0; r < 4; ++r) { o[vb][4 * j + r] = o0v[r] - lam * o[vb][4 * j + r]; ss += o[vb][4 * j + r] * o[vb][4 * j + r]; }
    }
  ss = xsum32(ss);
  const float rstd = rsqrtf(ss * (1.f / 128.f) + EPS) * (1.f - lam_init);
  const float* g = p.g_diff_out + l * 128;
#pragma unroll
  for (int vb = 0; vb < 4; ++vb) st_blk_scaled(dst + vb * 32, hh, o[vb], rstd, g + vb * 32);
}

__global__ void __launch_bounds__(512) mega(Params p) {
  extern __shared__ __attribute__((aligned(16))) char lds[];
  cg::grid_group grid = cg::this_grid();
  const int G = gridDim.x;

  for (int ph = p.ph_lo; ph < p.ph_hi; ++ph) {
    if ((ph % NSUB) == 0 && ph > 0) continue;
    if (ph != p.ph_lo) grid.sync();
    char* ws = get_ws(p);
    const int tid = get_tid(), lane = tid & 63, wave = tid >> 6, l32 = lane & 31, hh = lane >> 5;
    const int wf = wave >> 2, wt = wave & 3;
    const int l = ph / NSUB, sub = ph - l * NSUB;
    const float* xsrc = (l == 0) ? p.x : p.out;

    if (sub == 0) {
      const int n_rows = T_TOK / 8;
      const int n_cs = T_TOK * 16 / NT;
      const int total = n_rows + n_cs + 1;
      for (int w = blockIdx.x; w < total; w += G) {
        int i = w;
        if (i < n_rows) { xb_rows8(p.x, (u16*)(ws + OFF_H), (float*)(ws + OFF_SSX1), i); continue; }
        i -= n_rows;
        if (i < n_cs) cs_item(p, i); else misc_item(p);
      }
    } else if (sub == 1) {
      const int nmain = 128 * 11;
      for (int w = blockIdx.x; w < nmain + 32; w += G) {
        f32x16 acc[8]; zero4(acc); zero4(acc + 4);
        if (w < nmain) {
          int tt, ft; tile_map(w, 16, 11, 4, tt, ft);
          gemm_main<4, 2>((const u16*)(ws + OFF_WIN) + (size_t)ft * 256 * 1024, 1024, (const u16*)(ws + OFF_H) + (size_t)tt * 256 * 1024, 1024, 16, acc, lds);
#pragma unroll
          for (int tb = 0; tb < 2; ++tb) {
            const int t = tt * 256 + wt * 64 + tb * 32 + l32;
            const float r1 = rstd4((const float*)(ws + OFF_SSX1) + (size_t)(l & 1) * 4 * T_TOK, t);
#pragma unroll
            for (int fb = 0; fb < 4; ++fb)
#pragma unroll
              for (int i = 0; i < 16; ++i) acc[tb * 4 + fb][i] *= r1;
            g1_epilogue(p, l, t, ft * 2 + wf, acc + tb * 4, (p.flags & 1) == 0);
          }
        } else {
          const int mi = w - nmain; const int tt = mi >> 2, ft = mi & 3;
          gemm_main<4, 2>((const u16*)(ws + OFF_WMEM) + (size_t)ft * 256 * 1024, 1024, (const u16*)(ws + OFF_HM) + (size_t)tt * 256 * 1024, 1024, 16, acc, lds);
#pragma unroll
          for (int tb = 0; tb < 2; ++tb) memkv_epilogue(p, l, tt * 256 + wt * 64 + tb * 32 + l32, ft * 2 + wf, acc + tb * 4);
        }
      }
    } else if (sub == 2) {
      for (int w = blockIdx.x; w < 1024; w += G) {
        const int x = w & 7, j = w >> 3;
        const int jj = j & 63; const int tt = x * 16 + (jj >> 2), hp = jj & 3;
        f32x16 acc[8]; zero4(acc); zero4(acc + 4);
        if (j < 64) {
          gemm_main<3, 2>((const u16*)(ws + OFF_WUQ) + (size_t)hp * 192 * 384, 384, (const u16*)(ws + R_CQ) + (size_t)tt * 256 * 384, 384, 6, acc, lds);
#pragma unroll
          for (int tb = 0; tb < 2; ++tb) g2q_epilogue(p, l, tt * 256 + wt * 64 + tb * 32 + l32, hp * 2 + wf, acc + tb * 3);
        } else {
          gemm_main<4, 2>((const u16*)(ws + OFF_WUKV) + (size_t)hp * 256 * 256, 256, (const u16*)(ws + R_CKV) + (size_t)tt * 256 * 256, 256, 4, acc, lds);
#pragma unroll
          for (int tb = 0; tb < 2; ++tb) g2kv_epilogue(p, l, tt * 256 + wt * 64 + tb * 32 + l32, hp * 2 + wf, acc + tb * 4);
        }
      }
    } else if (sub == 3) {
      const int P = G >> 3; const int x = blockIdx.x & 7, j = blockIdx.x >> 3;
      if (j < P) {
        for (int r = 0; r * P < 256; ++r) {
          const int idx = r * P + ((r & 1) ? (P - 1 - j) : j);
          if (idx >= 256) continue;
          if (idx < 64) diff_item(p, l, x, idx & 3, 15 - (idx >> 2), lds);
          else if (idx < 192) { const int i2 = idx - 64; mla_item(p, x, i2 & 7, 15 - (i2 >> 3), lds); }
          else { const int i2 = idx - 192; cross_item(p, x, i2 & 3, i2 >> 2, lds); }
        }
      }
    } else if (sub == 4) {
      for (int w = blockIdx.x; w < 1024; w += G) {
        int tt, ft; tile_map(w, 32, 4, 4, tt, ft);
        unsigned yp[4][8];
        const float nr1 = -LOG2E * rstd4((const float*)(ws + OFF_SSX1) + (size_t)(l & 1) * 4 * T_TOK, tt * 128 + wt * 32 + l32);
#pragma unroll 1
        for (int n = 0; n < 3; ++n) {
          f32x16 acc[4]; zero4(acc);
          const size_t ooff = (n == 0) ? R_OA : (n == 1 ? R_OB : R_OC);
          gemm_main<4, 1>((const u16*)(ws + OFF_WBR) + ((size_t)n * 1024 + ft * 256) * 512, 512, (const u16*)(ws + ooff) + (size_t)tt * 128 * 512, 512, 8, acc, lds);
          unsigned bp[4][8];
#pragma unroll
          for (int fb = 0; fb < 4; ++fb)
#pragma unroll
            for (int i = 0; i < 8; ++i) bp[fb][i] = pack2(acc[fb][2 * i], acc[fb][2 * i + 1]);
          zero4(acc);
          gemm_main<4, 1>((const u16*)(ws + OFF_WG) + ((size_t)n * 1024 + ft * 256) * 1024, 1024, (const u16*)(ws + OFF_H) + (size_t)tt * 128 * 1024, 1024, 16, acc, lds);
#pragma unroll
          for (int fb = 0; fb < 4; ++fb)
#pragma unroll
            for (int i = 0; i < 8; ++i) {
              const float b0 = __uint_as_float(bp[fb][i] << 16), b1 = __uint_as_float(bp[fb][i] & 0xffff0000u);
              const float g0 = 1.f / (1.f + __builtin_amdgcn_exp2f(nr1 * acc[fb][2 * i]));
              const float g1 = 1.f / (1.f + __builtin_amdgcn_exp2f(nr1 * acc[fb][2 * i + 1]));
              float y0 = g0 * b0, y1 = g1 * b1;
              if (n > 0) { y0 += __uint_as_float(yp[fb][i] << 16); y1 += __uint_as_float(yp[fb][i] & 0xffff0000u); }
              yp[fb][i] = pack2(y0, y1);
            }
        }
        __syncthreads();
#pragma unroll
        for (int fb = 0; fb < 4; ++fb)
#pragma unroll
          for (int jq = 0; jq < 4; ++jq)
            *(uint2*)(lds + (wt * 32 + l32) * EROW + (wf * 128 + fb * 32 + 8 * jq + 4 * hh) * 2) = make_uint2(yp[fb][2 * jq], yp[fb][2 * jq + 1]);
        epi_flush<128>(lds, (u16*)(ws + R_Y) + (size_t)tt * 128 * 1024 + ft * 256, 1024);
      }
    } else if (sub == 5 || sub == 7) {
      const bool isO = (sub == 5);
      const u16* Wt = (const u16*)(ws + (isO ? OFF_WOUT : OFF_WFF2));
      const u16* Xa = (const u16*)(ws + (isO ? R_Y : R_U));
      const int K = isO ? 1024 : 4096;
      const float* xin = isO ? xsrc : p.out;
      float* ssacc = isO ? (float*)(ws + OFF_SSX2) : (float*)(ws + OFF_SSX1) + (size_t)((l + 1) & 1) * 4 * T_TOK;
      for (int w = blockIdx.x; w < 512; w += G) {
        int tt, ft; tile_map(w, 16, 4, 4, tt, ft);
        f32x16 acc[8]; zero4(acc); zero4(acc + 4);
        if (isO) gemm_main<4, 2>(Wt + (size_t)ft * 256 * K, K, Xa + (size_t)tt * 256 * K, K, K / 64, acc, lds);
        else gemm_main<4, 2>(Wt + (size_t)ft * 256 * K, 64, Xa + (size_t)tt * 256 * K, 64, K / 64, acc, lds, 256 * 64, 256 * 64);
        __syncthreads();
#pragma unroll
        for (int tb = 0; tb < 2; ++tb)
#pragma unroll
          for (int fb = 0; fb < 4; ++fb)
#pragma unroll
            for (int jq = 0; jq < 4; ++jq) {
              const f32x16& a = acc[tb * 4 + fb];
              epi_put4(lds, wt * 64 + tb * 32 + l32, wf * 128 + fb * 32 + 8 * jq + 4 * hh, a[4 * jq], a[4 * jq + 1], a[4 * jq + 2], a[4 * jq + 3]);
            }
        __syncthreads();
        {
          const int r0 = tid >> 5, ch = tid & 31;
#pragma unroll 4
          for (int it = 0; it < 16; ++it) {
            const int row = r0 + 16 * it;
            const int t = tt * 256 + row;
            const size_t off = (size_t)t * 1024 + ft * 256 + ch * 8;
            const u32x4 d = *(const u32x4*)(lds + row * EROW + ch * 16);
            float4 v0 = *(const float4*)(xin + off), v1 = *(const float4*)(xin + off + 4);
            v0.x += __uint_as_float(d.x << 16); v0.y += __uint_as_float(d.x & 0xffff0000u);
            v0.z += __uint_as_float(d.y << 16); v0.w += __uint_as_float(d.y & 0xffff0000u);
            v1.x += __uint_as_float(d.z << 16); v1.y += __uint_as_float(d.z & 0xffff0000u);
            v1.z += __uint_as_float(d.w << 16); v1.w += __uint_as_float(d.w & 0xffff0000u);
            __builtin_nontemporal_store(__builtin_bit_cast(u32x4, v0), (u32x4*)(p.out + off));
            __builtin_nontemporal_store(__builtin_bit_cast(u32x4, v1), (u32x4*)(p.out + off + 4));
            u32x4 xb4;
            xb4.x = pack2(v0.x, v0.y); xb4.y = pack2(v0.z, v0.w); xb4.z = pack2(v1.x, v1.y); xb4.w = pack2(v1.z, v1.w);
            *(u32x4*)((u16*)(ws + OFF_H) + off) = xb4;
            float ss = v0.x * v0.x + v0.y * v0.y + v0.z * v0.z + v0.w * v0.w + v1.x * v1.x + v1.y * v1.y + v1.z * v1.z + v1.w * v1.w;
#pragma unroll
            for (int o = 16; o >= 1; o >>= 1) ss += __shfl_xor(ss, o);
            if (ch == 0) ssacc[(size_t)ft * T_TOK + t] = ss;
          }
        }
      }
    } else if (sub == 6) {
      for (int w = blockIdx.x; w < 2048; w += G) {
        int tt, ft; tile_map(w, 16, 16, 4, tt, ft);
        f32x16 acc[8]; zero4(acc); zero4(acc + 4);
        gemm_main<4, 2>((const u16*)(ws + OFF_WFF1) + (size_t)ft * 256 * 1024, 1024, (const u16*)(ws + OFF_H) + (size_t)tt * 256 * 1024, 1024, 16, acc, lds);
        __syncthreads();
        float r2[2];
#pragma unroll
        for (int tb = 0; tb < 2; ++tb) r2[tb] = rstd4((const float*)(ws + OFF_SSX2), tt * 256 + wt * 64 + tb * 32 + l32);
#pragma unroll
        for (int tb = 0; tb < 2; ++tb)
#pragma unroll
          for (int fb = 0; fb < 4; ++fb)
#pragma unroll
            for (int jq = 0; jq < 4; ++jq) {
              const f32x16& a = acc[tb * 4 + fb];
              const float a0 = fmaxf(a[4 * jq], 0.f) * r2[tb], a1 = fmaxf(a[4 * jq + 1], 0.f) * r2[tb], a2 = fmaxf(a[4 * jq + 2], 0.f) * r2[tb], a3 = fmaxf(a[4 * jq + 3], 0.f) * r2[tb];
              epi_put4(lds, wt * 64 + tb * 32 + l32, wf * 128 + fb * 32 + 8 * jq + 4 * hh, a0 * a0, a1 * a1, a2 * a2, a3 * a3);
            }
        {
          const int r0 = tid >> 5, ch = tid & 31;
          u16* ub = (u16*)(ws + R_U) + ((size_t)(tt * 64 + ft * 4 + (ch >> 3)) * 256) * 64 + (ch & 7) * 8;
          __syncthreads();
#pragma unroll 4
          for (int r = r0; r < 256; r += 16) __builtin_nontemporal_store(*(const u32x4*)(lds + r * EROW + ch * 16), (u32x4*)(ub + (size_t)r * 64));
        }
      }
    }
    {
      int cv_l = 0, cv_lo = 0, cv_n = 0, cv_mem = 0;
      if (sub == 0) { cv_l = 0; cv_lo = 0; cv_n = NCONV / 2; cv_mem = 256; }
      else if (sub == 7 && l < 3) { cv_l = l + 1; cv_lo = 0; cv_n = 1764; cv_mem = 256; }
      else if (sub == 1 && l > 0) { cv_l = l; cv_lo = 1764; cv_n = 512; }
      for (int w2 = blockIdx.x; w2 < cv_n + cv_mem; w2 += G) {
        if (w2 < cv_n) conv_item(p, cv_l, cv_lo + w2, lds);
        else norm_rows8(p.mem, p.g_mem + cv_l * 1024, (u16*)(ws + OFF_HM), w2 - cv_n);
      }
    }
  }
}

extern "C" void kernel_launch(void* const* d_in, const int* in_sizes, int n_in, void* d_out, int out_size, void* d_ws, size_t ws_size,
                              hipStream_t stream) {
  static int grid_blocks = 0;
  if (grid_blocks == 0) {
    if (n_in != 28 || ws_size < WS_END) { fprintf(stderr, "kernel_launch: bad config n_in=%d ws=%zu need=%zu\n", n_in, ws_size, (size_t)WS_END); grid_blocks = -1; return; }
    int dev = 0, cus = 0, per_cu = 0;
    (void)hipGetDevice(&dev);
    (void)hipDeviceGetAttribute(&cus, hipDeviceAttributeMultiprocessorCount, dev);
    (void)hipFuncSetAttribute((const void*)mega, hipFuncAttributeMaxDynamicSharedMemorySize, LDS_BYTES);
    (void)hipOccupancyMaxActiveBlocksPerMultiprocessor(&per_cu, (const void*)mega, NT, LDS_BYTES);
    if (per_cu < 1) fprintf(stderr, "kernel_launch: occupancy query says %d blocks/CU\n", per_cu);
    grid_blocks = cus;
    (void)hipGetLastError();
  }
  if (grid_blocks < 0) return;
  Params p{};
  p.x = (const float*)d_in[0]; p.mem = (const float*)d_in[1]; p.pos = (const int*)d_in[2]; p.t5 = (const float*)d_in[3];
  p.g_mix = (const float*)d_in[4]; p.g_mem = (const float*)d_in[5]; p.w_in = (const float*)d_in[6]; p.g_cq = (const float*)d_in[7];
  p.w_uq = (const float*)d_in[8]; p.g_ckv = (const float*)d_in[9]; p.w_ukv = (const float*)d_in[10]; p.g_mla_q = (const float*)d_in[11];
  p.g_mla_k = (const float*)d_in[12]; p.g_diff_q = (const float*)d_in[13]; p.g_diff_k = (const float*)d_in[14];
  p.lam_q1 = (const float*)d_in[15]; p.lam_k1 = (const float*)d_in[16]; p.lam_q2 = (const float*)d_in[17]; p.lam_k2 = (const float*)d_in[18];
  p.g_diff_out = (const float*)d_in[19]; p.w_mem_kv = (const float*)d_in[20]; p.g_mem_q = (const float*)d_in[21]; p.g_mem_k = (const float*)d_in[22];
  p.w_branch = (const float*)d_in[23]; p.w_out = (const float*)d_in[24]; p.g_mlp = (const float*)d_in[25]; p.w_ff1 = (const float*)d_in[26];
  p.w_ff2 = (const float*)d_in[27];
  p.out = (float*)d_out; p.ws = (char*)d_ws;
  const int nph = 4 * NSUB;
#if SINGLE_LAUNCH
  p.ph_lo = 0; p.ph_hi = nph;
  { void* args[] = {&p};
    hipError_t e = hipLaunchCooperativeKernel((const void*)mega, dim3(grid_blocks), dim3(NT), args, LDS_BYTES, stream);
    if (e != hipSuccess) fprintf(stderr, "cooperative launch failed: %s (grid %d)\n", hipGetErrorString(e), grid_blocks); }
#else
  for (int ph = 0; ph < nph; ++ph) {
    p.ph_lo = ph; p.ph_hi = ph + 1;
    void* args[] = {&p};
    hipError_t e = hipLaunchCooperativeKernel((const void*)mega, dim3(grid_blocks), dim3(NT), args, LDS_BYTES, stream);
    if (e != hipSuccess) { fprintf(stderr, "cooperative launch failed: %s (grid %d)\n", hipGetErrorString(e), grid_blocks); break; }
    if (DUP_SUB >= 0 && (ph % NSUB) == DUP_SUB) {
      p.flags = 1;
      (void)hipLaunchCooperativeKernel((const void*)mega, dim3(grid_blocks), dim3(NT), args, LDS_BYTES, stream);
      p.flags = 0;
    }
  }
#endif
}
```

```cpp
#include <hip/hip_runtime.h>
#include <hip/hip_cooperative_groups.h>
#include <cstdio>
namespace cg = cooperative_groups;

typedef unsigned short u16;
typedef __attribute__((ext_vector_type(8))) short bf16x8;
typedef __attribute__((ext_vector_type(16))) float f32x16;
typedef __bf16 bf2_t __attribute__((ext_vector_type(2)));
typedef float f2_t __attribute__((ext_vector_type(2)));

#define DI __device__ __forceinline__

#ifndef DUP_SUB
#define DUP_SUB -1
#endif
#ifndef SINGLE_LAUNCH
#define SINGLE_LAUNCH 1
#endif

constexpr int T_TOK = 32768;
constexpr int SEQ = 4096;
constexpr float LOG2E = 1.4426950408889634f;
constexpr float EPS = 1e-6f;
constexpr int NT = 512;
constexpr int LUT_OFF = 147456;
constexpr int LDS_BYTES = LUT_OFF + 1280;
constexpr int NSUB = 8;

constexpr size_t SZ_WIN = 2816ull * 1024 * 2, SZ_WG = 3072ull * 1024 * 2, SZ_WUQ = 768ull * 384 * 2, SZ_WUKV = 1024ull * 256 * 2,
                 SZ_WMEM = 1024ull * 1024 * 2, SZ_WBR = 3ull * 1024 * 512 * 2, SZ_WOUT = 1024ull * 1024 * 2, SZ_WFF = 4096ull * 1024 * 2;
constexpr size_t OFF_WIN = 0;
constexpr size_t OFF_WG = OFF_WIN + SZ_WIN;
constexpr size_t OFF_WUQ = OFF_WG + SZ_WG;
constexpr size_t OFF_WUKV = OFF_WUQ + SZ_WUQ;
constexpr size_t OFF_WMEM = OFF_WUKV + SZ_WUKV;
constexpr size_t OFF_WBR = OFF_WMEM + SZ_WMEM;
constexpr size_t OFF_WOUT = OFF_WBR + SZ_WBR;
constexpr size_t OFF_WFF1 = OFF_WOUT + SZ_WOUT;
constexpr size_t OFF_WFF2 = OFF_WFF1 + SZ_WFF;
constexpr size_t OFF_H = OFF_WFF2 + SZ_WFF;
constexpr size_t OFF_HM = OFF_H + (size_t)T_TOK * 1024 * 2;
constexpr size_t OFF_CS = OFF_HM + 2048ull * 1024 * 2;
constexpr size_t OFF_SSQ = OFF_CS + (size_t)T_TOK * 32 * 4;
constexpr size_t OFF_SSKV = OFF_SSQ + (size_t)T_TOK * 12;
constexpr size_t OFF_SSX2 = OFF_SSKV + (size_t)T_TOK * 8;
constexpr size_t OFF_SSX1 = OFF_SSX2 + (size_t)T_TOK * 16;
constexpr size_t OFF_MISC = OFF_SSX1 + (size_t)T_TOK * 32;
constexpr size_t OFF_R = OFF_MISC + 4096;
constexpr size_t R_CQ = OFF_R;
constexpr size_t R_CKV = R_CQ + (size_t)T_TOK * 384 * 2;
constexpr size_t R_KR = R_CKV + (size_t)T_TOK * 256 * 2;
constexpr size_t R_DQ = R_KR + (size_t)T_TOK * 32 * 4;
constexpr size_t R_DK = R_DQ + (size_t)T_TOK * 512 * 2;
constexpr size_t R_DV = R_DK + (size_t)T_TOK * 512 * 2;
constexpr size_t R_MQ = R_DV + (size_t)T_TOK * 512 * 2;
constexpr size_t R_Q = R_MQ + (size_t)T_TOK * 512 * 2;
constexpr size_t R_K = R_Q + (size_t)T_TOK * 768 * 2;
constexpr size_t R_V = R_K + (size_t)T_TOK * 768 * 2;
constexpr size_t R_KM = R_V + (size_t)T_TOK * 512 * 2;
constexpr size_t R_VM = R_KM + 2048ull * 512 * 2;
constexpr size_t R_OB = R_VM + 2048ull * 512 * 2;
constexpr size_t R_OC = R_OB + (size_t)T_TOK * 512 * 2;
constexpr size_t WS_END = R_OC + (size_t)T_TOK * 512 * 2;
constexpr size_t R_OA = R_CQ;
constexpr size_t R_Y = R_DQ;
constexpr size_t R_U = OFF_R;
static_assert(R_U + (size_t)T_TOK * 4096 * 2 <= WS_END, "u must fit in region");

struct Params {
  const float* x; const float* mem; const int* pos; const float* t5;
  const float* g_mix; const float* g_mem; const float* w_in; const float* g_cq; const float* w_uq; const float* g_ckv; const float* w_ukv;
  const float* g_mla_q; const float* g_mla_k; const float* g_diff_q; const float* g_diff_k;
  const float* lam_q1; const float* lam_k1; const float* lam_q2; const float* lam_k2; const float* g_diff_out;
  const float* w_mem_kv; const float* g_mem_q; const float* g_mem_k; const float* w_branch; const float* w_out; const float* g_mlp;
  const float* w_ff1; const float* w_ff2;
  float* out; char* ws;
  int ph_lo, ph_hi, flags, pad_;
};

DI int get_tid() { int t = threadIdx.x; asm volatile("" : "+v"(t)); return t; }
DI char* get_ws(const Params& p) { char* w = p.ws; asm volatile("" : "+s"(w)); return w; }
typedef unsigned u32x4 __attribute__((ext_vector_type(4)));
typedef const __attribute__((address_space(1))) u32x4* gu4p;
DI u32x4 ldg16(const void* p) { return *(gu4p)(p); }
DI unsigned pack2(float a, float b) { f2_t v = {a, b}; bf2_t r = __builtin_convertvector(v, bf2_t); return __builtin_bit_cast(unsigned, r); }
DI u16 tobf(float a) { return (u16)(pack2(a, 0.f) & 0xffffu); }
DI float xor32(float v) { return __shfl_xor(v, 32); }
DI float xsum32(float v) { const auto r = __builtin_amdgcn_permlane32_swap(__float_as_uint(v), __float_as_uint(v), false, false); return __uint_as_float(r[0]) + __uint_as_float(r[1]); }
DI float xmax32(float v) { const auto r = __builtin_amdgcn_permlane32_swap(__float_as_uint(v), __float_as_uint(v), false, false); return fmaxf(__uint_as_float(r[0]), __uint_as_float(r[1])); }
DI f32x16 mfma(bf16x8 a, bf16x8 b, f32x16 c) { return __builtin_amdgcn_mfma_f32_32x32x16_bf16(a, b, c, 0, 0, 0); }
DI float sumsq16(const f32x16& v) { float s = 0.f;
#pragma unroll
  for (int i = 0; i < 16; ++i) s += v[i] * v[i];
  return s; }
DI int perm16(int s) { return (s & ~12) | ((s & 4) << 1) | ((s & 8) >> 1); }
DI void st4(u16* dst, float a, float b, float c, float d) { uint2 o; o.x = pack2(a, b); o.y = pack2(c, d); *(uint2*)dst = o; }

DI void st_blk(u16* blk, int hh, const float* v) {
#pragma unroll
  for (int jp = 0; jp < 2; ++jp) {
    const unsigned ax = pack2(v[8 * jp + 0], v[8 * jp + 1]), ay = pack2(v[8 * jp + 2], v[8 * jp + 3]);
    const unsigned bx = pack2(v[8 * jp + 4], v[8 * jp + 5]), by = pack2(v[8 * jp + 6], v[8 * jp + 7]);
    const auto r1 = __builtin_amdgcn_permlane32_swap(ax, bx, false, false);
    const auto r2 = __builtin_amdgcn_permlane32_swap(ay, by, false, false);
    u32x4 o; o.x = r1[0]; o.y = r2[0]; o.z = r1[1]; o.w = r2[1];
    *(u32x4*)(blk + 16 * jp + 8 * hh) = o;
  }
}
DI void st_blk_plain(u16* blk, int hh, const f32x16& a) {
  float v[16];
#pragma unroll
  for (int i = 0; i < 16; ++i) v[i] = a[i];
  st_blk(blk, hh, v);
}
DI void st_blk_scaled(u16* blk, int hh, const f32x16& a, float rstd, const float* __restrict__ gblk) {
  float v[16];
#pragma unroll
  for (int j = 0; j < 4; ++j) {
    const float4 gv = *(const float4*)(gblk + 8 * j + 4 * hh);
    v[4 * j] = a[4 * j] * rstd * gv.x; v[4 * j + 1] = a[4 * j + 1] * rstd * gv.y; v[4 * j + 2] = a[4 * j + 2] * rstd * gv.z; v[4 * j + 3] = a[4 * j + 3] * rstd * gv.w;
  }
  st_blk(blk, hh, v);
}
DI void zero4(f32x16* acc) {
#pragma unroll
  for (int f = 0; f < 4; ++f)
#pragma unroll
    for (int i = 0; i < 16; ++i) acc[f][i] = 0.f;
}

constexpr int LROW = 144;
constexpr int GBUF = 512 * LROW;
constexpr int DROW = 128;
constexpr int DBUF = 512 * DROW;
typedef __attribute__((address_space(3))) void* lds_vp_t;
typedef const __attribute__((address_space(1))) void* glb_vp_t;
template <int NFB, int NTB>
DI void gemm_main(const u16* __restrict__ W, int ldw, const u16* __restrict__ X, int ldx, int nk, f32x16* acc, char* lds, int kws = 64, int kxs = 64) {
  constexpr int NAC = (2 * NFB * 32) / 64;
  constexpr int NBC = (4 * NTB * 32) / 64;
  constexpr int NPER = NAC + NBC;
  const int tid = get_tid(), lane = tid & 63, wave = tid >> 6, l32 = lane & 31, hh = lane >> 5;
  const int wf = wave >> 2, wt = wave & 3;
  const int crow = tid >> 3, q = tid & 7;
  const int gc = q ^ ((crow >> 1) & 7);
  const u16* wp = W + (size_t)crow * ldw + gc * 8;
  const u16* xp = X + (size_t)crow * ldx + gc * 8;
  char* lw = lds + tid * 16;
  const int xr = (l32 >> 1) & 7;
  const int abase = (wf * NFB * 32 + l32) * DROW;
  const int bbase = 256 * DROW + (wt * NTB * 32 + l32) * DROW;
#define DMA_ISSUE(STAGE, KTILE)                                                                                              \
  {                                                                                                                          \
    const size_t kw_ = (size_t)(KTILE) * kws, kx_ = (size_t)(KTILE) * kxs;                                                   \
    char* d_ = lw + (STAGE) * DBUF;                                                                                          \
    _Pragma("unroll") for (int i = 0; i < NAC; ++i)                                                                          \
      __builtin_amdgcn_global_load_lds((glb_vp_t)(wp + (size_t)(64 * i) * ldw + kw_), (lds_vp_t)(d_ + 64 * i * DROW), 16, 0, 0); \
    _Pragma("unroll") for (int i = 0; i < NBC; ++i)                                                                          \
      __builtin_amdgcn_global_load_lds((glb_vp_t)(xp + (size_t)(64 * i) * ldx + kx_), (lds_vp_t)(d_ + 256 * DROW + 64 * i * DROW), 16, 0, 0); \
  }
  __syncthreads();
  DMA_ISSUE(0, 0)
  asm volatile("s_waitcnt vmcnt(0)" ::: "memory");
  __builtin_amdgcn_s_barrier();
  for (int kt = 0; kt < nk; ++kt) {
    const char* cur = lds + (kt & 1) * DBUF;
    if (kt + 1 < nk) DMA_ISSUE((kt + 1) & 1, kt + 1)
#pragma unroll(NTB == 1 ? 2 : 4)
    for (int s = 0; s < 4; ++s) {
      const int ro = ((2 * s + hh) ^ xr) * 16;
      bf16x8 bfr[NTB];
#pragma unroll
      for (int tb = 0; tb < NTB; ++tb) bfr[tb] = *(const bf16x8*)(cur + bbase + tb * 32 * DROW + ro);
#pragma unroll
      for (int fb = 0; fb < NFB; ++fb) {
        const bf16x8 afr = *(const bf16x8*)(cur + abase + fb * 32 * DROW + ro);
#pragma unroll
        for (int tb = 0; tb < NTB; ++tb) acc[tb * NFB + fb] = mfma(afr, bfr[tb], acc[tb * NFB + fb]);
      }
    }
    asm volatile("s_waitcnt vmcnt(0) lgkmcnt(0)" ::: "memory");
    __builtin_amdgcn_s_barrier();
  }
#undef DMA_ISSUE
}

constexpr int EROW = 528;
constexpr int FROW = 1040;
DI void epi_put4(char* lds, int row, int col, float a, float b, float c, float d) {
  uint2 o; o.x = pack2(a, b); o.y = pack2(c, d);
  *(uint2*)(lds + row * EROW + col * 2) = o;
}
template <int ROWS>
DI void epi_flush(char* lds, u16* __restrict__ dst, size_t ld) {
  const int tid = get_tid();
  const int r0 = tid >> 5, ch = tid & 31;
  __syncthreads();
#pragma unroll 4
  for (int r = r0; r < ROWS; r += 16) {
    const u32x4 v = *(const u32x4*)(lds + r * EROW + ch * 16);
    *(u32x4*)(dst + (size_t)r * ld + ch * 8) = v;
  }
}

DI float rstd4(const float* ssp, int t) {
  return rsqrtf((ssp[t] + ssp[T_TOK + t] + ssp[2 * T_TOK + t] + ssp[3 * T_TOK + t]) * (1.f / 1024.f) + EPS);
}

DI void tile_map(int w, int tpx, int nft, int gf, int& tt, int& ft) {
  const int x = w & 7, j = w >> 3;
  const int pg = tpx * gf;
  int fg = j / pg; const int nfull = nft / gf; int gs = gf;
  if (fg >= nfull) { fg = nfull; gs = nft - gf * nfull; }
  const int r = j - fg * pg;
  const int per = 8 * gs;
  const int tg = r / per; const int r2 = r - tg * per;
  ft = fg * gf + (r2 >> 3);
  tt = x * tpx + tg * 8 + (r2 & 7);
}

DI void norm_rows8(const float* __restrict__ x, const float* __restrict__ g, u16* __restrict__ h, int item) {
  const int tid_ = get_tid(); const int lane = tid_ & 63, wave = tid_ >> 6;
  const size_t row = (size_t)item * 8 + wave;
  const float4* xr = (const float4*)(x + row * 1024);
  float4 v[4]; float ss = 0.f;
#pragma unroll
  for (int i = 0; i < 4; ++i) { v[i] = xr[lane + 64 * i]; ss += v[i].x * v[i].x + v[i].y * v[i].y + v[i].z * v[i].z + v[i].w * v[i].w; }
#pragma unroll
  for (int o = 32; o >= 1; o >>= 1) ss += __shfl_xor(ss, o);
  const float rstd = rsqrtf(ss * (1.f / 1024.f) + EPS);
#pragma unroll
  for (int i = 0; i < 4; ++i) {
    const float4 gv = ((const float4*)g)[lane + 64 * i];
    st4(h + row * 1024 + (size_t)(lane + 64 * i) * 4, v[i].x * rstd * gv.x, v[i].y * rstd * gv.y, v[i].z * rstd * gv.z, v[i].w * rstd * gv.w);
  }
}


DI void xb_rows8(const float* __restrict__ x, u16* __restrict__ xb, float* __restrict__ ssx, int item) {
  const int tid_ = get_tid(); const int lane = tid_ & 63, wave = tid_ >> 6;
  const size_t row = (size_t)item * 8 + wave;
  const float4* xr = (const float4*)(x + row * 1024);
  float ss = 0.f;
#pragma unroll
  for (int i = 0; i < 4; ++i) {
    const float4 v = xr[lane + 64 * i];
    ss += v.x * v.x + v.y * v.y + v.z * v.z + v.w * v.w;
    st4(xb + row * 1024 + (size_t)(lane + 64 * i) * 4, v.x, v.y, v.z, v.w);
  }
#pragma unroll
  for (int o = 32; o >= 1; o >>= 1) ss += __shfl_xor(ss, o);
  if (lane < 4) ssx[(size_t)lane * T_TOK + row] = (lane == 0) ? ss : 0.f;
}

DI void conv_tile(const float* __restrict__ src, int ld, int mode, int colbase, int f0, int k0, int K, u16* __restrict__ dst,
                  const float* __restrict__ gs, char* lds, bool blocked) {
  const int tid512 = get_tid();
  const int tid = tid512 & 255;
  float (*tile)[65] = (float (*)[65])(lds + (tid512 >> 8) * 16640);
  __syncthreads();
  {
    const int c4 = tid & 15, r0 = tid >> 4;
    const int fp = f0 + c4 * 4;
    int col;
    if (mode == 0) col = colbase + fp;
    else col = fp < 640 ? fp : (fp < 2688 ? fp + 32 : (fp < 2720 ? fp - 2688 + 640 : -1));
#pragma unroll
    for (int i = 0; i < 4; ++i) {
      const int k = r0 + 16 * i;
      float4 v = make_float4(0.f, 0.f, 0.f, 0.f);
      if (col >= 0) v = *(const float4*)(src + (size_t)(k0 + k) * ld + col);
      const float s = gs ? gs[k0 + k] : 1.f;
      tile[k][c4 * 4 + 0] = v.x * s; tile[k][c4 * 4 + 1] = v.y * s; tile[k][c4 * 4 + 2] = v.z * s; tile[k][c4 * 4 + 3] = v.w * s;
    }
  }
  __syncthreads();
  {
    const int f = tid >> 2, kq = (tid & 3) * 16;
    unsigned o[8];
#pragma unroll
    for (int j = 0; j < 8; ++j) o[j] = pack2(tile[kq + 2 * j][f], tile[kq + 2 * j + 1][f]);
    uint4* d = blocked ? (uint4*)(dst + ((size_t)((f0 >> 8) * (K >> 6) + (k0 >> 6)) * 256 + (f0 & 255) + f) * 64 + kq)
                       : (uint4*)(dst + (size_t)(f0 + f) * K + k0 + kq);
    d[0] = make_uint4(o[0], o[1], o[2], o[3]);
    d[1] = make_uint4(o[4], o[5], o[6], o[7]);
  }
}

constexpr int NCONV = 704 + 768 + 72 + 64 + 256 + 384 + 256 + 1024 + 1024;
DI void conv_item(const Params& p, int l, int item, char* lds) {
  char* ws = get_ws(p);
  int idx = item * 2 + (get_tid() >> 8);
  const float* src; int ld, mode = 0, colbase = 0, f0, k0, K; u16* dst; const float* gs = nullptr; bool blocked = false;
  if (idx < 704) { src = p.w_in + (size_t)l * 1024 * 5792; ld = 5792; mode = 1; f0 = (idx >> 4) * 64; k0 = (idx & 15) * 64; K = 1024; dst = (u16*)(ws + OFF_WIN); gs = p.g_mix + l * 1024; }
  else if ((idx -= 704) < 768) { src = p.w_in + (size_t)l * 1024 * 5792; ld = 5792; colbase = 2720; f0 = (idx >> 4) * 64; k0 = (idx & 15) * 64; K = 1024; dst = (u16*)(ws + OFF_WG); gs = p.g_mix + l * 1024; }
  else if ((idx -= 768) < 72) { src = p.w_uq + (size_t)l * 384 * 768; ld = 768; f0 = (idx / 6) * 64; k0 = (idx % 6) * 64; K = 384; dst = (u16*)(ws + OFF_WUQ); gs = p.g_cq + l * 384; }
  else if ((idx -= 72) < 64) { src = p.w_ukv + (size_t)l * 256 * 1024; ld = 1024; f0 = (idx >> 2) * 64; k0 = (idx & 3) * 64; K = 256; dst = (u16*)(ws + OFF_WUKV); gs = p.g_ckv + l * 256; }
  else if ((idx -= 64) < 256) { src = p.w_mem_kv + (size_t)l * 1024 * 1024; ld = 1024; f0 = (idx >> 4) * 64; k0 = (idx & 15) * 64; K = 1024; dst = (u16*)(ws + OFF_WMEM); }
  else if ((idx -= 256) < 384) { const int n = idx >> 7, r = idx & 127; src = p.w_branch + (size_t)(l * 3 + n) * 512 * 1024; ld = 1024; f0 = (r >> 3) * 64; k0 = (r & 7) * 64; K = 512; dst = (u16*)(ws + OFF_WBR) + (size_t)n * 1024 * 512; }
  else if ((idx -= 384) < 256) { src = p.w_out + (size_t)l * 1024 * 1024; ld = 1024; f0 = (idx >> 4) * 64; k0 = (idx & 15) * 64; K = 1024; dst = (u16*)(ws + OFF_WOUT); }
  else if ((idx -= 256) < 1024) { src = p.w_ff1 + (size_t)l * 1024 * 4096; ld = 4096; f0 = (idx >> 4) * 64; k0 = (idx & 15) * 64; K = 1024; dst = (u16*)(ws + OFF_WFF1); gs = p.g_mlp + l * 1024; }
  else { idx -= 1024; src = p.w_ff2 + (size_t)l * 4096 * 1024; ld = 1024; f0 = (idx >> 6) * 64; k0 = (idx & 63) * 64; K = 4096; dst = (u16*)(ws + OFF_WFF2); blocked = true; }
  conv_tile(src, ld, mode, colbase, f0, k0, K, dst, gs, lds, blocked);
}

DI void cs_item(const Params& p, int item) {
  const int e = item * NT + get_tid();
  const int t = e >> 4, i = e & 15;
  const float inv = __builtin_amdgcn_exp2f(-(float)i * 0.8304820237218405f);
  const float angf = (float)p.pos[t] * inv;
  const double rev = (double)angf * 0.15915494309189535;
  const float fr = (float)(rev - rint(rev));
  float2* cs = (float2*)(get_ws(p) + OFF_CS);
  cs[e] = make_float2(__builtin_amdgcn_cosf(fr), __builtin_amdgcn_sinf(fr));
}
DI void misc_item(const Params& p) {
  const int tid = get_tid();
  int* kpmax = (int*)(p.ws + OFF_MISC);
  for (int tile = tid; tile < 512; tile += NT) {
    int mx = p.pos[tile * 64];
    for (int k = 1; k < 64; ++k) mx = max(mx, p.pos[tile * 64 + k]);
    kpmax[tile] = mx;
  }
  if (tid < 4) {
    float d1 = 0.f, d2 = 0.f;
    for (int k = 0; k < 64; ++k) { d1 += p.lam_q1[tid * 64 + k] * p.lam_k1[tid * 64 + k]; d2 += p.lam_q2[tid * 64 + k] * p.lam_k2[tid * 64 + k]; }
    const float lam_init = 0.8f - 0.6f * expf(-0.3f * (float)tid);
    float* lam = (float*)(p.ws + OFF_MISC + 2048);
    lam[tid] = expf(d1) - expf(d2) + lam_init;
  }
}

DI void g1_epilogue(const Params& p, int l, int t, int ft, f32x16* acc, bool do_atomic) {
  char* ws = get_ws(p);
  const int tid_ = get_tid(); const int lane = tid_ & 63, wave = tid_ >> 6, l32 = lane & 31, hh = lane >> 5;
  const int b = t >> 12, s = t & 4095;
  if (ft < 5) {
    u16* dst; float* ssp;
    if (ft < 3) { dst = (u16*)(ws + R_CQ) + (size_t)t * 384 + ft * 128; ssp = (float*)(ws + OFF_SSQ) + (size_t)ft * T_TOK + t; }
    else { dst = (u16*)(ws + R_CKV) + (size_t)t * 256 + (ft - 3) * 128; ssp = (float*)(ws + OFF_SSKV) + (size_t)(ft - 3) * T_TOK + t; }
    float ss = 0.f;
#pragma unroll
    for (int fb = 0; fb < 4; ++fb) {
      ss += sumsq16(acc[fb]);
      st_blk_plain(dst + fb * 32, hh, acc[fb]);
    }
    ss = xsum32(ss);
    if (hh == 0) *ssp = ss;
  } else if (ft < 13) {
    const bool isq = ft < 9; const int head = isq ? ft - 5 : ft - 9;
    const float* g = (isq ? p.g_diff_q : p.g_diff_k) + l * 64;
    u16* base = (u16*)(ws + (isq ? R_DQ : R_DK));
    const float mul = isq ? 0.125f * LOG2E : 1.f;
#pragma unroll
    for (int c = 0; c < 2; ++c) {
      float ss = sumsq16(acc[2 * c]) + sumsq16(acc[2 * c + 1]);
      ss = xsum32(ss);
      const float rstd = rsqrtf(ss * (1.f / 64.f) + EPS) * mul;
      u16* dst = base + (((size_t)(b * 4 + head) * 2 + c) * 4096 + s) * 64;
#pragma unroll
      for (int fbb = 0; fbb < 2; ++fbb) st_blk_scaled(dst + fbb * 32, hh, acc[2 * c + fbb], rstd, g + fbb * 32);
    }
  } else if (ft < 17) {
    const int head = ft - 13;
    u16* dst = (u16*)(ws + R_DV) + ((size_t)(b * 4 + head) * 128) * 4096 + perm16(s);
#pragma unroll
    for (int fb = 0; fb < 4; ++fb)
#pragma unroll
      for (int i = 0; i < 16; ++i) {
        const int d = fb * 32 + 8 * (i >> 2) + 4 * hh + (i & 3);
        dst[(size_t)d * 4096] = tobf(acc[fb][i]);
      }
  } else if (ft < 21) {
    const int head = ft - 17;
    float ss = sumsq16(acc[0]) + sumsq16(acc[1]) + sumsq16(acc[2]) + sumsq16(acc[3]);
    ss = xsum32(ss);
    const float rstd = rsqrtf(ss * (1.f / 128.f) + EPS) * (0.08838834764831845f * LOG2E);
    const float* g = p.g_mem_q + l * 128;
    u16* dst = (u16*)(ws + R_MQ) + ((size_t)(b * 4 + head) * 4096 + s) * 128;
#pragma unroll
    for (int fb = 0; fb < 4; ++fb) st_blk_scaled(dst + fb * 32, hh, acc[fb], rstd, g + fb * 32);
  } else {
    float* dst = (float*)(ws + R_KR) + (size_t)t * 32;
#pragma unroll
    for (int j = 0; j < 4; ++j) *(float4*)(dst + 8 * j + 4 * hh) = make_float4(acc[0][4 * j], acc[0][4 * j + 1], acc[0][4 * j + 2], acc[0][4 * j + 3]);
  }
}

DI void memkv_epilogue(const Params& p, int l, int mt, int ft, f32x16* acc) {
  char* ws = get_ws(p);
  const int tid_ = get_tid(); const int lane = tid_ & 63, wave = tid_ >> 6, l32 = lane & 31, hh = lane >> 5;
  const int b = mt >> 8, m = mt & 255;
  if (ft < 4) {
    const int head = ft;
    float ss = sumsq16(acc[0]) + sumsq16(acc[1]) + sumsq16(acc[2]) + sumsq16(acc[3]);
    ss = xsum32(ss);
    const float rstd = rsqrtf(ss * (1.f / 128.f) + EPS);
    const float* g = p.g_mem_k + l * 128;
    u16* dst = (u16*)(ws + R_KM) + ((size_t)(b * 4 + head) * 256 + m) * 128;
#pragma unroll
    for (int fb = 0; fb < 4; ++fb) st_blk_scaled(dst + fb * 32, hh, acc[fb], rstd, g + fb * 32);
  } else {
    const int head = ft - 4;
    u16* dst = (u16*)(ws + R_VM) + ((size_t)(b * 4 + head) * 128) * 256 + perm16(m);
#pragma unroll
    for (int fb = 0; fb < 4; ++fb)
#pragma unroll
      for (int i = 0; i < 16; ++i) {
        const int d = fb * 32 + 8 * (i >> 2) + 4 * hh + (i & 3);
        dst[(size_t)d * 256] = tobf(acc[fb][i]);
      }
  }
}

DI void g2q_epilogue(const Params& p, int l, int t, int head, f32x16* acc) {
  char* ws = get_ws(p);
  const int tid_ = get_tid(); const int lane = tid_ & 63, wave = tid_ >> 6, l32 = lane & 31, hh = lane >> 5;
  const int b = t >> 12, s = t & 4095;
  const float* sq = (const float*)(ws + OFF_SSQ);
  const float rcq = rsqrtf((sq[t] + sq[T_TOK + t] + sq[2 * T_TOK + t]) * (1.f / 384.f) + EPS);
  float ss = 0.f;
#pragma unroll
  for (int fb = 0; fb < 3; ++fb)
#pragma unroll
    for (int i = 0; i < 16; ++i) { acc[fb][i] *= rcq; ss += acc[fb][i] * acc[fb][i]; }
  ss = xsum32(ss);
  const float qs = 0.10206207261596577f * LOG2E;
  const float rstd = rsqrtf(ss * (1.f / 96.f) + EPS) * qs;
  const float* g = p.g_mla_q + l * 96;
  u16* dst = (u16*)(ws + R_Q) + ((size_t)(b * 8 + head) * 4096 + s) * 96;
#pragma unroll
  for (int fb = 0; fb < 2; ++fb)
#pragma unroll
    for (int j = 0; j < 4; ++j) {
      const int d = fb * 32 + 8 * j + 4 * hh;
      const float4 gv = *(const float4*)(g + d);
      st4(dst + d, acc[fb][4 * j] * rstd * gv.x, acc[fb][4 * j + 1] * rstd * gv.y, acc[fb][4 * j + 2] * rstd * gv.z, acc[fb][4 * j + 3] * rstd * gv.w);
    }
  const float* cs = (const float*)(ws + OFF_CS) + (size_t)t * 32;
#pragma unroll
  for (int j = 0; j < 2; ++j) {
    const int i0 = 8 * j + 4 * hh;
    const float4 c01 = *(const float4*)(cs + 2 * i0), c23 = *(const float4*)(cs + 2 * i0 + 4);
    const float cc[4] = {c01.x, c01.z, c23.x, c23.z}, sn[4] = {c01.y, c01.w, c23.y, c23.w};
    const float4 g1 = *(const float4*)(g + 64 + i0), g2 = *(const float4*)(g + 80 + i0);
    const float g1a[4] = {g1.x, g1.y, g1.z, g1.w}, g2a[4] = {g2.x, g2.y, g2.z, g2.w};
    float o1[4], o2[4];
#pragma unroll
    for (int r = 0; r < 4; ++r) {
      const float x1 = acc[2][4 * j + r] * rstd * g1a[r], x2 = acc[2][4 * (j + 2) + r] * rstd * g2a[r];
      o1[r] = x1 * cc[r] - x2 * sn[r]; o2[r] = x2 * cc[r] + x1 * sn[r];
    }
    st4(dst + 64 + i0, o1[0], o1[1], o1[2], o1[3]);
    st4(dst + 80 + i0, o2[0], o2[1], o2[2], o2[3]);
  }
}

DI void g2kv_epilogue(const Params& p, int l, int t, int head, f32x16* acc) {
  char* ws = get_ws(p);
  const int tid_ = get_tid(); const int lane = tid_ & 63, wave = tid_ >> 6, l32 = lane & 31, hh = lane >> 5;
  const int b = t >> 12, s = t & 4095;
  const float* skv = (const float*)(ws + OFF_SSKV);
  const float rckv = rsqrtf((skv[t] + skv[T_TOK + t]) * (1.f / 256.f) + EPS);
  float ss = 0.f;
#pragma unroll
  for (int fb = 0; fb < 4; ++fb)
#pragma unroll
    for (int i = 0; i < 16; ++i) acc[fb][i] *= rckv;
  ss = sumsq16(acc[0]) + sumsq16(acc[1]);
  const float* krp = (const float*)(ws + R_KR) + (size_t)t * 32;
  float kr[16];
#pragma unroll
  for (int j = 0; j < 4; ++j) {
    const float4 v = *(const float4*)(krp + 8 * j + 4 * hh);
    kr[4 * j] = v.x; kr[4 * j + 1] = v.y; kr[4 * j + 2] = v.z; kr[4 * j + 3] = v.w;
    ss += v.x * v.x + v.y * v.y + v.z * v.z + v.w * v.w;
  }
  ss = xsum32(ss);
  const float rstd = rsqrtf(ss * (1.f / 96.f) + EPS);
  const float* g = p.g_mla_k + l * 96;
  u16* dst = (u16*)(ws + R_K) + ((size_t)(b * 8 + head) * 4096 + s) * 96;
#pragma unroll
  for (int fb = 0; fb < 2; ++fb)
#pragma unroll
    for (int j = 0; j < 4; ++j) {
      const int d = fb * 32 + 8 * j + 4 * hh;
      const float4 gv = *(const float4*)(g + d);
      st4(dst + d, acc[fb][4 * j] * rstd * gv.x, acc[fb][4 * j + 1] * rstd * gv.y, acc[fb][4 * j + 2] * rstd * gv.z, acc[fb][4 * j + 3] * rstd * gv.w);
    }
  const float* cs = (const float*)(ws + OFF_CS) + (size_t)t * 32;
#pragma unroll
  for (int j = 0; j < 2; ++j) {
    const int i0 = 8 * j + 4 * hh;
    const float4 c01 = *(const float4*)(cs + 2 * i0), c23 = *(const float4*)(cs + 2 * i0 + 4);
    const float cc[4] = {c01.x, c01.z, c23.x, c23.z}, sn[4] = {c01.y, c01.w, c23.y, c23.w};
    const float4 g1 = *(const float4*)(g + 64 + i0), g2 = *(const float4*)(g + 80 + i0);
    const float g1a[4] = {g1.x, g1.y, g1.z, g1.w}, g2a[4] = {g2.x, g2.y, g2.z, g2.w};
    float o1[4], o2[4];
#pragma unroll
    for (int r = 0; r < 4; ++r) {
      const float x1 = kr[4 * j + r] * rstd * g1a[r], x2 = kr[4 * (j + 2) + r] * rstd * g2a[r];
      o1[r] = x1 * cc[r] - x2 * sn[r]; o2[r] = x2 * cc[r] + x1 * sn[r];
    }
    st4(dst + 64 + i0, o1[0], o1[1], o1[2], o1[3]);
    st4(dst + 80 + i0, o2[0], o2[1], o2[2], o2[3]);
  }
  u16* vdst = (u16*)(ws + R_V) + ((size_t)(b * 8 + head) * 64) * 4096 + perm16(s);
#pragma unroll
  for (int fb = 2; fb < 4; ++fb)
#pragma unroll
    for (int i = 0; i < 16; ++i) {
      const int d = (fb - 2) * 32 + 8 * (i >> 2) + 4 * hh + (i & 3);
      vdst[(size_t)d * 4096] = tobf(acc[fb][i]);
    }
}

template <int DQK, int DV, bool BIAS>
DI void attn_tile(const char* cur, const bf16x8* qf, f32x16* o, float& m, float& lsum, int kt, int l32, int hh,
                  const int* __restrict__ posb, int qpos, int qmin, const int* __restrict__ kpmax, const float* lut) {
  constexpr int KROW = DQK * 2 + 16, VROW = 144, KB = 64 * KROW;
      f32x16 s0, s1;
#pragma unroll
      for (int i = 0; i < 16; ++i) { s0[i] = 0.f; s1[i] = 0.f; }
#pragma unroll
      for (int st = 0; st < DQK / 16; ++st) {
        const bf16x8 a0 = *(const bf16x8*)(cur + l32 * KROW + st * 32 + hh * 16);
        const bf16x8 a1 = *(const bf16x8*)(cur + (32 + l32) * KROW + st * 32 + hh * 16);
        s0 = mfma(a0, qf[st], s0);
        s1 = mfma(a1, qf[st], s1);
      }
      float cb = 0.f;
      if (BIAS) {
        const int kmx = kpmax[kt];
        if (kmx - qmin <= -128) {
          cb = lut[0];
        } else {
#pragma unroll
          for (int j = 0; j < 4; ++j) {
            const int4 k0 = *(const int4*)(posb + kt * 64 + 8 * j + 4 * hh);
            const int4 k1 = *(const int4*)(posb + kt * 64 + 32 + 8 * j + 4 * hh);
            const int ka[4] = {k0.x, k0.y, k0.z, k0.w}, kb[4] = {k1.x, k1.y, k1.z, k1.w};
#pragma unroll
            for (int r = 0; r < 4; ++r) {
              s0[4 * j + r] += lut[min(max(ka[r] - qpos, -128), 128) + 128];
              s1[4 * j + r] += lut[min(max(kb[r] - qpos, -128), 128) + 128];
            }
          }
        }
      }
      float mx = s0[0];
#pragma unroll
      for (int i = 1; i < 16; ++i) mx = fmaxf(mx, s0[i]);
#pragma unroll
      for (int i = 0; i < 16; ++i) mx = fmaxf(mx, s1[i]);
      mx = xmax32(mx) + cb;
      if (__any(mx > m + 8.f)) {
        const float mnew = fmaxf(m, mx);
        const float alpha = __builtin_amdgcn_exp2f(m - mnew);
        m = mnew;
        lsum *= alpha;
#pragma unroll
        for (int vb = 0; vb < DV / 32; ++vb)
#pragma unroll
          for (int i = 0; i < 16; ++i) o[vb][i] *= alpha;
      }
      const float sh = m - cb;
      float rs = 0.f;
#pragma unroll
      for (int i = 0; i < 16; ++i) { s0[i] = __builtin_amdgcn_exp2f(s0[i] - sh); rs += s0[i]; }
#pragma unroll
      for (int i = 0; i < 16; ++i) { s1[i] = __builtin_amdgcn_exp2f(s1[i] - sh); rs += s1[i]; }
      lsum += rs;
      bf16x8 pf[4];
#pragma unroll
      for (int ks = 0; ks < 4; ++ks) {
        const f32x16& sv = (ks < 2) ? s0 : s1;
        const int b0 = (ks & 1) * 8;
        uint4 u;
        u.x = pack2(sv[b0 + 0], sv[b0 + 1]); u.y = pack2(sv[b0 + 2], sv[b0 + 3]);
        u.z = pack2(sv[b0 + 4], sv[b0 + 5]); u.w = pack2(sv[b0 + 6], sv[b0 + 7]);
        pf[ks] = __builtin_bit_cast(bf16x8, u);
      }
#pragma unroll
      for (int vb = 0; vb < DV / 32; ++vb)
#pragma unroll
        for (int ks = 0; ks < 4; ++ks) {
          const bf16x8 a = *(const bf16x8*)(cur + KB + (vb * 32 + l32) * VROW + ks * 32 + hh * 16);
          o[vb] = mfma(a, pf[ks], o[vb]);
        }
    }

template <int DQK, int DV, bool BIAS>
DI void attn_ring(const bf16x8* qf, const u16* __restrict__ Kg, const u16* __restrict__ Vg, int ldv, int nt_wg, int nt_wave,
                  f32x16* o, char* lds, const int* __restrict__ posb, int qpos, int qmin, const int* __restrict__ kpmax, const float* lut) {
  constexpr int KROW = DQK * 2 + 16, VROW = 144;
  constexpr int KB = 64 * KROW, VB = DV * VROW, STAGE = KB + VB;
  constexpr int CPR = DQK / 8;
  constexpr int KCH = 64 * CPR;
  constexpr int NKC = (KCH + NT - 1) / NT;
  constexpr int NVC = DV * 8 / NT;
  static_assert(4 * STAGE <= LUT_OFF, "lds");
  const int tid = get_tid(), lane = tid & 63, l32 = lane & 31, hh = lane >> 5;
  int koff[NKC], kch[NKC];
#pragma unroll
  for (int i = 0; i < NKC; ++i) { const int c = min(tid + NT * i, KCH - 1); kch[i] = c * 8; koff[i] = (c / CPR) * KROW + (c % CPR) * 16; }
  const int vrow = tid >> 3, vcol = tid & 7;
  float m = -INFINITY, lsum = 0.f;
#pragma unroll
  for (int vb = 0; vb < DV / 32; ++vb)
#pragma unroll
    for (int i = 0; i < 16; ++i) o[vb][i] = 0.f;
  u32x4 rk[2][NKC], rv[2][NVC];
  const int last = nt_wg - 1;
#define RING_LOAD(T0)                                                                                                     \
  _Pragma("unroll") for (int h_ = 0; h_ < 2; ++h_) {                                                                      \
    const int t_ = min((T0) + h_, last);                                                                                  \
    _Pragma("unroll") for (int i = 0; i < NKC; ++i) rk[h_][i] = ldg16(Kg + (size_t)t_ * 64 * DQK + kch[i]);               \
    _Pragma("unroll") for (int i = 0; i < NVC; ++i) rv[h_][i] = ldg16(Vg + (size_t)(vrow + 64 * i) * ldv + t_ * 64 + vcol * 8); \
  }
#define RING_STORE(DS)                                                                                                    \
  _Pragma("unroll") for (int h_ = 0; h_ < 2; ++h_) {                                                                      \
    char* d_ = lds + ((DS) * 2 + h_) * STAGE;                                                                             \
    _Pragma("unroll") for (int i = 0; i < NKC; ++i) *(u32x4*)(d_ + koff[i]) = rk[h_][i];                                  \
    _Pragma("unroll") for (int i = 0; i < NVC; ++i) *(u32x4*)(d_ + KB + (vrow + 64 * i) * VROW + vcol * 16) = rv[h_][i];  \
  }
  __syncthreads();
  RING_LOAD(0)
  RING_STORE(0)
  RING_LOAD(2)
  __syncthreads();
  for (int j = 0; 2 * j < nt_wg; ++j) {
    RING_STORE((j + 1) & 1)
    RING_LOAD(2 * j + 4)
    __builtin_amdgcn_sched_barrier(0);
    const char* st = lds + (j & 1) * 2 * STAGE;
#pragma unroll 1
    for (int h2 = 0; h2 < 2; ++h2) {
      const int kt = 2 * j + h2;
      if (kt < nt_wave) attn_tile<DQK, DV, BIAS>(st + h2 * STAGE, qf, o, m, lsum, kt, l32, hh, posb, qpos, qmin, kpmax, lut);
    }
    __syncthreads();
  }
#undef RING_STORE
#undef RING_LOAD
  const float lt = xsum32(lsum);
  const float inv = 1.f / lt;
#pragma unroll
  for (int vb = 0; vb < DV / 32; ++vb)
#pragma unroll
    for (int i = 0; i < 16; ++i) o[vb][i] *= inv;
}

template <int DQK, int DV, bool BIAS, bool PF>
DI void attn_loop(const bf16x8* qf, const u16* __restrict__ Kg, const u16* __restrict__ Vg, int ldv, int nt_wg, int nt_wave,
                  f32x16* o, char* lds, const int* __restrict__ posb, int qpos, int qmin, const int* __restrict__ kpmax, const float* lut) {
  constexpr int KROW = DQK * 2 + 16, VROW = 144;
  constexpr int KB = 64 * KROW, VB = DV * VROW, STAGE = KB + VB;
  constexpr int CPR = DQK / 8;
  constexpr int KCH = 64 * CPR;
  constexpr int NKC = (KCH + NT - 1) / NT;
  constexpr int NVC = DV * 8 / NT;
  static_assert(2 * STAGE <= LUT_OFF, "lds");
  const int tid = get_tid(), lane = tid & 63, l32 = lane & 31, hh = lane >> 5;
  int koff[NKC], kch[NKC];
#pragma unroll
  for (int i = 0; i < NKC; ++i) { const int c = min(tid + NT * i, KCH - 1); kch[i] = c * 8; koff[i] = (c / CPR) * KROW + (c % CPR) * 16; }
  const int vrow = tid >> 3, vcol = tid & 7;
  float m = -INFINITY, lsum = 0.f;
#pragma unroll
  for (int vb = 0; vb < DV / 32; ++vb)
#pragma unroll
    for (int i = 0; i < 16; ++i) o[vb][i] = 0.f;
  u32x4 rk[NKC], rv[NVC];
  if (PF) {
    __syncthreads();
#pragma unroll
    for (int i = 0; i < NKC; ++i) rk[i] = ldg16(Kg + kch[i]);
#pragma unroll
    for (int i = 0; i < NVC; ++i) rv[i] = ldg16(Vg + (size_t)(vrow + 64 * i) * ldv + vcol * 8);
#pragma unroll
    for (int i = 0; i < NKC; ++i) *(u32x4*)(lds + koff[i]) = rk[i];
#pragma unroll
    for (int i = 0; i < NVC; ++i) *(u32x4*)(lds + KB + (vrow + 64 * i) * VROW + vcol * 16) = rv[i];
    __syncthreads();
  }
  for (int kt = 0; kt < nt_wg; ++kt) {
    const char* cur = PF ? lds + (kt & 1) * STAGE : lds;
    const bool more = (kt + 1) < nt_wg;
    if (PF) {
      const int ktn = more ? kt + 1 : kt;
#pragma unroll
      for (int i = 0; i < NKC; ++i) rk[i] = ldg16(Kg + (size_t)ktn * 64 * DQK + kch[i]);
#pragma unroll
      for (int i = 0; i < NVC; ++i) rv[i] = ldg16(Vg + (size_t)(vrow + 64 * i) * ldv + ktn * 64 + vcol * 8);
      __builtin_amdgcn_sched_barrier(0);
    } else {
      __syncthreads();
#pragma unroll
      for (int i = 0; i < NKC; ++i) rk[i] = ldg16(Kg + (size_t)kt * 64 * DQK + kch[i]);
#pragma unroll
      for (int i = 0; i < NVC; ++i) rv[i] = ldg16(Vg + (size_t)(vrow + 64 * i) * ldv + kt * 64 + vcol * 8);
#pragma unroll
      for (int i = 0; i < NKC; ++i) *(u32x4*)(lds + koff[i]) = rk[i];
#pragma unroll
      for (int i = 0; i < NVC; ++i) *(u32x4*)(lds + KB + (vrow + 64 * i) * VROW + vcol * 16) = rv[i];
      __syncthreads();
    }
    if (kt < nt_wave) {
      f32x16 s0, s1;
#pragma unroll
      for (int i = 0; i < 16; ++i) { s0[i] = 0.f; s1[i] = 0.f; }
#pragma unroll
      for (int st = 0; st < DQK / 16; ++st) {
        const bf16x8 a0 = *(const bf16x8*)(cur + l32 * KROW + st * 32 + hh * 16);
        const bf16x8 a1 = *(const bf16x8*)(cur + (32 + l32) * KROW + st * 32 + hh * 16);
        s0 = mfma(a0, qf[st], s0);
        s1 = mfma(a1, qf[st], s1);
      }
      float cb = 0.f;
      if (BIAS) {
        const int kmx = kpmax[kt];
        if (kmx - qmin <= -128) {
          cb = lut[0];
        } else {
#pragma unroll
          for (int j = 0; j < 4; ++j) {
            const int4 k0 = *(const int4*)(posb + kt * 64 + 8 * j + 4 * hh);
            const int4 k1 = *(const int4*)(posb + kt * 64 + 32 + 8 * j + 4 * hh);
            const int ka[4] = {k0.x, k0.y, k0.z, k0.w}, kb[4] = {k1.x, k1.y, k1.z, k1.w};
#pragma unroll
            for (int r = 0; r < 4; ++r) {
              s0[4 * j + r] += lut[min(max(ka[r] - qpos, -128), 128) + 128];
              s1[4 * j + r] += lut[min(max(kb[r] - qpos, -128), 128) + 128];
            }
          }
        }
      }
      float mx = s0[0];
#pragma unroll
      for (int i = 1; i < 16; ++i) mx = fmaxf(mx, s0[i]);
#pragma unroll
      for (int i = 0; i < 16; ++i) mx = fmaxf(mx, s1[i]);
      mx = xmax32(mx) + cb;
      if (__any(mx > m + 8.f)) {
        const float mnew = fmaxf(m, mx);
        const float alpha = __builtin_amdgcn_exp2f(m - mnew);
        m = mnew;
        lsum *= alpha;
#pragma unroll
        for (int vb = 0; vb < DV / 32; ++vb)
#pragma unroll
          for (int i = 0; i < 16; ++i) o[vb][i] *= alpha;
      }
      const float sh = m - cb;
      float rs = 0.f;
#pragma unroll
      for (int i = 0; i < 16; ++i) { s0[i] = __builtin_amdgcn_exp2f(s0[i] - sh); rs += s0[i]; }
#pragma unroll
      for (int i = 0; i < 16; ++i) { s1[i] = __builtin_amdgcn_exp2f(s1[i] - sh); rs += s1[i]; }
      lsum += rs;
      bf16x8 pf[4];
#pragma unroll
      for (int ks = 0; ks < 4; ++ks) {
        const f32x16& sv = (ks < 2) ? s0 : s1;
        const int b0 = (ks & 1) * 8;
        uint4 u;
        u.x = pack2(sv[b0 + 0], sv[b0 + 1]); u.y = pack2(sv[b0 + 2], sv[b0 + 3]);
        u.z = pack2(sv[b0 + 4], sv[b0 + 5]); u.w = pack2(sv[b0 + 6], sv[b0 + 7]);
        pf[ks] = __builtin_bit_cast(bf16x8, u);
      }
#pragma unroll
      for (int vb = 0; vb < DV / 32; ++vb)
#pragma unroll
        for (int ks = 0; ks < 4; ++ks) {
          const bf16x8 a = *(const bf16x8*)(cur + KB + (vb * 32 + l32) * VROW + ks * 32 + hh * 16);
          o[vb] = mfma(a, pf[ks], o[vb]);
        }
    }
    if (PF) {
      __builtin_amdgcn_sched_barrier(0);
      {
        char* nxt = lds + ((kt + 1) & 1) * STAGE;
#pragma unroll
        for (int i = 0; i < NKC; ++i) *(u32x4*)(nxt + koff[i]) = rk[i];
#pragma unroll
        for (int i = 0; i < NVC; ++i) *(u32x4*)(nxt + KB + (vrow + 64 * i) * VROW + vcol * 16) = rv[i];
      }
      __syncthreads();
    }
  }
  const float lt = xsum32(lsum);
  const float inv = 1.f / lt;
#pragma unroll
  for (int vb = 0; vb < DV / 32; ++vb)
#pragma unroll
    for (int i = 0; i < 16; ++i) o[vb][i] *= inv;
}

DI void mla_item(const Params& p, int b, int h, int qb, char* lds) {
  char* ws = get_ws(p);
  const int tid_ = get_tid(); const int lane = tid_ & 63, wave = tid_ >> 6, l32 = lane & 31, hh = lane >> 5;
  const int s = qb * 256 + wave * 32 + l32; const int t = b * 4096 + s;
  const u16* qp = (const u16*)(ws + R_Q) + ((size_t)(b * 8 + h) * 4096 + s) * 96;
  bf16x8 qf[6];
#pragma unroll
  for (int st = 0; st < 6; ++st) qf[st] = *(const bf16x8*)(qp + st * 16 + hh * 8);
  f32x16 o[2];
  attn_ring<96, 64, false>(qf, (const u16*)(ws + R_K) + (size_t)(b * 8 + h) * 4096 * 96, (const u16*)(ws + R_V) + (size_t)(b * 8 + h) * 64 * 4096,
                           4096, 4 * qb + 4, 4 * qb + 1 + (wave >> 1), o, lds, nullptr, 0, 0, nullptr, nullptr);
  u16* dst = (u16*)(ws + R_OA) + (size_t)t * 512 + h * 64;
#pragma unroll
  for (int vb = 0; vb < 2; ++vb) st_blk_plain(dst + vb * 32, hh, o[vb]);
}

DI void cross_item(const Params& p, int b, int h, int qb, char* lds) {
  char* ws = get_ws(p);
  const int tid_ = get_tid(); const int lane = tid_ & 63, wave = tid_ >> 6, l32 = lane & 31, hh = lane >> 5;
  const int s = qb * 256 + wave * 32 + l32; const int t = b * 4096 + s;
  const u16* qp = (const u16*)(ws + R_MQ) + ((size_t)(b * 4 + h) * 4096 + s) * 128;
  bf16x8 qf[8];
#pragma unroll
  for (int st = 0; st < 8; ++st) qf[st] = *(const bf16x8*)(qp + st * 16 + hh * 8);
  f32x16 o[4];
  attn_loop<128, 128, false, false>(qf, (const u16*)(ws + R_KM) + (size_t)(b * 4 + h) * 256 * 128, (const u16*)(ws + R_VM) + (size_t)(b * 4 + h) * 128 * 256,
                             256, 4, 4, o, lds, nullptr, 0, 0, nullptr, nullptr);
  u16* dst = (u16*)(ws + R_OC) + (size_t)t * 512 + h * 128;
#pragma unroll
  for (int vb = 0; vb < 4; ++vb) st_blk_plain(dst + vb * 32, hh, o[vb]);
}

DI void diff_item(const Params& p, int l, int b, int h, int qb, char* lds) {
  char* ws = get_ws(p);
  const int tid = get_tid(), lane = tid & 63, wave = tid >> 6, l32 = lane & 31, hh = lane >> 5;
  float* lut = (float*)(lds + LUT_OFF);
  __syncthreads();
  for (int idx = tid; idx < 257; idx += NT) {
    const int rel = idx - 128; const int a = rel < 0 ? -rel : rel;
    int v;
    if (a < 8) v = a;
    else { const float af = (float)a; v = min(8 + (int)(logf(af / 8.f) / 2.772588722239781f * 8.f), 15); }
    const int bucket = (rel > 0 ? 16 : 0) + v;
    lut[idx] = p.t5[bucket * 4 + h] * LOG2E;
  }
  const int s = qb * 256 + wave * 32 + l32; const int t = b * 4096 + s;
  const int qpos = p.pos[t];
  int qmin = qpos;
#pragma unroll
  for (int o = 16; o >= 1; o >>= 1) qmin = min(qmin, __shfl_xor(qmin, o));
  const float lam = ((const float*)(ws + OFF_MISC + 2048))[l];
  const float lam_init = 0.8f - 0.6f * expf(-0.3f * (float)l);
  const int* kpmax = (const int*)(ws + OFF_MISC) + b * 64;
  const int* posb = p.pos + b * 4096;
  const u16* vg = (const u16*)(ws + R_DV) + (size_t)(b * 4 + h) * 128 * 4096;
  f32x16 o[4];
  u16* dst = (u16*)(ws + R_OB) + (size_t)t * 512 + h * 128;
#pragma unroll
  for (int c = 0; c < 2; ++c) {
    const u16* qp = (const u16*)(ws + R_DQ) + (((size_t)(b * 4 + h) * 2 + c) * 4096 + s) * 64;
    bf16x8 qf[4];
#pragma unroll
    for (int st = 0; st < 4; ++st) qf[st] = *(const bf16x8*)(qp + st * 16 + hh * 8);
    attn_ring<64, 128, true>(qf, (const u16*)(ws + R_DK) + ((size_t)(b * 4 + h) * 2 + c) * 4096 * 64, vg, 4096, 4 * qb + 4, 4 * qb + 1 + (wave >> 1),
                             o, lds, posb, qpos, qmin, kpmax, lut);
    if (c == 0) {
#pragma unroll
      for (int vb = 0; vb < 4; ++vb)
#pragma unroll
        for (int j = 0; j < 4; ++j) st4(dst + vb * 32 + 8 * j + 4 * hh, o[vb][4 * j], o[vb][4 * j + 1], o[vb][4 * j + 2], o[vb][4 * j + 3]);
    }
  }
  float ss = 0.f;
#pragma unroll
  for (int vb = 0; vb < 4; ++vb)
#pragma unroll
    for (int j = 0; j < 4; ++j) {
      const uint2 pk = *(const uint2*)(dst + vb * 32 + 8 * j + 4 * hh);
      const float o0v[4] = {__uint_as_float(pk.x << 16), __uint_as_float(pk.x & 0xffff0000u), __uint_as_float(pk.y << 16), __uint_as_float(pk.y & 0xffff0000u)};
#pragma unroll
      for (int r = 0; r < 4; ++r) { o[vb][4 * j + r] = o0v[r] - lam * o[vb][4 * j + r]; ss += o[vb][4 * j + r] * o[vb][4 * j + r]; }
    }
  ss = xsum32(ss);
  const float rstd = rsqrtf(ss * (1.f / 128.f) + EPS) * (1.f - lam_init);
  const float* g = p.g_diff_out + l * 128;
#pragma unroll
  for (int vb = 0; vb < 4; ++vb) st_blk_scaled(dst + vb * 32, hh, o[vb], rstd, g + vb * 32);
}

__global__ void __launch_bounds__(512) mega(Params p) {
  extern __shared__ __attribute__((aligned(16))) char lds[];
  cg::grid_group grid = cg::this_grid();
  const int G = gridDim.x;

  for (int ph = p.ph_lo; ph < p.ph_hi; ++ph) {
    if ((ph % NSUB) == 0 && ph > 0) continue;
    if (ph != p.ph_lo) grid.sync();
    char* ws = get_ws(p);
    const int tid = get_tid(), lane = tid & 63, wave = tid >> 6, l32 = lane & 31, hh = lane >> 5;
    const int wf = wave >> 2, wt = wave & 3;
    const int l = ph / NSUB, sub = ph - l * NSUB;
    const float* xsrc = (l == 0) ? p.x : p.out;

    if (sub == 0) {
      const int n_rows = T_TOK / 8;
      const int n_cs = T_TOK * 16 / NT;
      const int total = n_rows + n_cs + 1;
      for (int w = blockIdx.x; w < total; w += G) {
        int i = w;
        if (i < n_rows) { xb_rows8(p.x, (u16*)(ws + OFF_H), (float*)(ws + OFF_SSX1), i); continue; }
        i -= n_rows;
        if (i < n_cs) cs_item(p, i); else misc_item(p);
      }
    } else if (sub == 1) {
      const int nmain = 128 * 11;
      for (int w = blockIdx.x; w < nmain + 32; w += G) {
        f32x16 acc[8]; zero4(acc); zero4(acc + 4);
        if (w < nmain) {
          int tt, ft; tile_map(w, 16, 11, 4, tt, ft);
          gemm_main<4, 2>((const u16*)(ws + OFF_WIN) + (size_t)ft * 256 * 1024, 1024, (const u16*)(ws + OFF_H) + (size_t)tt * 256 * 1024, 1024, 16, acc, lds);
#pragma unroll
          for (int tb = 0; tb < 2; ++tb) {
            const int t = tt * 256 + wt * 64 + tb * 32 + l32;
            const float r1 = rstd4((const float*)(ws + OFF_SSX1) + (size_t)(l & 1) * 4 * T_TOK, t);
#pragma unroll
            for (int fb = 0; fb < 4; ++fb)
#pragma unroll
              for (int i = 0; i < 16; ++i) acc[tb * 4 + fb][i] *= r1;
            g1_epilogue(p, l, t, ft * 2 + wf, acc + tb * 4, (p.flags & 1) == 0);
          }
        } else {
          const int mi = w - nmain; const int tt = mi >> 2, ft = mi & 3;
          gemm_main<4, 2>((const u16*)(ws + OFF_WMEM) + (size_t)ft * 256 * 1024, 1024, (const u16*)(ws + OFF_HM) + (size_t)tt * 256 * 1024, 1024, 16, acc, lds);
#pragma unroll
          for (int tb = 0; tb < 2; ++tb) memkv_epilogue(p, l, tt * 256 + wt * 64 + tb * 32 + l32, ft * 2 + wf, acc + tb * 4);
        }
      }
    } else if (sub == 2) {
      for (int w = blockIdx.x; w < 1024; w += G) {
        const int x = w & 7, j = w >> 3;
        const int jj = j & 63; const int tt = x * 16 + (jj >> 2), hp = jj & 3;
        f32x16 acc[8]; zero4(acc); zero4(acc + 4);
        if (j < 64) {
          gemm_main<3, 2>((const u16*)(ws + OFF_WUQ) + (size_t)hp * 192 * 384, 384, (const u16*)(ws + R_CQ) + (size_t)tt * 256 * 384, 384, 6, acc, lds);
#pragma unroll
          for (int tb = 0; tb < 2; ++tb) g2q_epilogue(p, l, tt * 256 + wt * 64 + tb * 32 + l32, hp * 2 + wf, acc + tb * 3);
        } else {
          gemm_main<4, 2>((const u16*)(ws + OFF_WUKV) + (size_t)hp * 256 * 256, 256, (const u16*)(ws + R_CKV) + (size_t)tt * 256 * 256, 256, 4, acc, lds);
#pragma unroll
          for (int tb = 0; tb < 2; ++tb) g2kv_epilogue(p, l, tt * 256 + wt * 64 + tb * 32 + l32, hp * 2 + wf, acc + tb * 4);
        }
      }
    } else if (sub == 3) {
      const int P = G >> 3; const int x = blockIdx.x & 7, j = blockIdx.x >> 3;
      if (j < P) {
        for (int r = 0; r * P < 256; ++r) {
          const int idx = r * P + ((r & 1) ? (P - 1 - j) : j);
          if (idx >= 256) continue;
          if (idx < 64) diff_item(p, l, x, idx & 3, 15 - (idx >> 2), lds);
          else if (idx < 192) { const int i2 = idx - 64; mla_item(p, x, i2 & 7, 15 - (i2 >> 3), lds); }
          else { const int i2 = idx - 192; cross_item(p, x, i2 & 3, i2 >> 2, lds); }
        }
      }
    } else if (sub == 4) {
      for (int w = blockIdx.x; w < 1024; w += G) {
        int tt, ft; tile_map(w, 32, 4, 4, tt, ft);
        unsigned yp[4][8];
        const float nr1 = -LOG2E * rstd4((const float*)(ws + OFF_SSX1) + (size_t)(l & 1) * 4 * T_TOK, tt * 128 + wt * 32 + l32);
#pragma unroll 1
        for (int n = 0; n < 3; ++n) {
          f32x16 acc[4]; zero4(acc);
          const size_t ooff = (n == 0) ? R_OA : (n == 1 ? R_OB : R_OC);
          gemm_main<4, 1>((const u16*)(ws + OFF_WBR) + ((size_t)n * 1024 + ft * 256) * 512, 512, (const u16*)(ws + ooff) + (size_t)tt * 128 * 512, 512, 8, acc, lds);
          unsigned bp[4][8];
#pragma unroll
          for (int fb = 0; fb < 4; ++fb)
#pragma unroll
            for (int i = 0; i < 8; ++i) bp[fb][i] = pack2(acc[fb][2 * i], acc[fb][2 * i + 1]);
          zero4(acc);
          gemm_main<4, 1>((const u16*)(ws + OFF_WG) + ((size_t)n * 1024 + ft * 256) * 1024, 1024, (const u16*)(ws + OFF_H) + (size_t)tt * 128 * 1024, 1024, 16, acc, lds);
#pragma unroll
          for (int fb = 0; fb < 4; ++fb)
#pragma unroll
            for (int i = 0; i < 8; ++i) {
              const float b0 = __uint_as_float(bp[fb][i] << 16), b1 = __uint_as_float(bp[fb][i] & 0xffff0000u);
              const float g0 = 1.f / (1.f + __builtin_amdgcn_exp2f(nr1 * acc[fb][2 * i]));
              const float g1 = 1.f / (1.f + __builtin_amdgcn_exp2f(nr1 * acc[fb][2 * i + 1]));
              float y0 = g0 * b0, y1 = g1 * b1;
              if (n > 0) { y0 += __uint_as_float(yp[fb][i] << 16); y1 += __uint_as_float(yp[fb][i] & 0xffff0000u); }
              yp[fb][i] = pack2(y0, y1);
            }
        }
        __syncthreads();
#pragma unroll
        for (int fb = 0; fb < 4; ++fb)
#pragma unroll
          for (int jq = 0; jq < 4; ++jq)
            *(uint2*)(lds + (wt * 32 + l32) * EROW + (wf * 128 + fb * 32 + 8 * jq + 4 * hh) * 2) = make_uint2(yp[fb][2 * jq], yp[fb][2 * jq + 1]);
        epi_flush<128>(lds, (u16*)(ws + R_Y) + (size_t)tt * 128 * 1024 + ft * 256, 1024);
      }
    } else if (sub == 5 || sub == 7) {
      const bool isO = (sub == 5);
      const u16* Wt = (const u16*)(ws + (isO ? OFF_WOUT : OFF_WFF2));
      const u16* Xa = (const u16*)(ws + (isO ? R_Y : R_U));
      const int K = isO ? 1024 : 4096;
      const float* xin = isO ? xsrc : p.out;
      float* ssacc = isO ? (float*)(ws + OFF_SSX2) : (float*)(ws + OFF_SSX1) + (size_t)((l + 1) & 1) * 4 * T_TOK;
      for (int w = blockIdx.x; w < 512; w += G) {
        int tt, ft; tile_map(w, 16, 4, 4, tt, ft);
        f32x16 acc[8]; zero4(acc); zero4(acc + 4);
        if (isO) gemm_main<4, 2>(Wt + (size_t)ft * 256 * K, K, Xa + (size_t)tt * 256 * K, K, K / 64, acc, lds);
        else gemm_main<4, 2>(Wt + (size_t)ft * 256 * K, 64, Xa + (size_t)tt * 256 * K, 64, K / 64, acc, lds, 256 * 64, 256 * 64);
        __syncthreads();
#pragma unroll
        for (int tb = 0; tb < 2; ++tb)
#pragma unroll
          for (int fb = 0; fb < 4; ++fb)
#pragma unroll
            for (int jq = 0; jq < 4; ++jq) {
              const f32x16& a = acc[tb * 4 + fb];
              epi_put4(lds, wt * 64 + tb * 32 + l32, wf * 128 + fb * 32 + 8 * jq + 4 * hh, a[4 * jq], a[4 * jq + 1], a[4 * jq + 2], a[4 * jq + 3]);
            }
        __syncthreads();
        {
          const int r0 = tid >> 5, ch = tid & 31;
#pragma unroll 8
          for (int it = 0; it < 16; ++it) {
            const int row = r0 + 16 * it;
            const int t = tt * 256 + row;
            const size_t off = (size_t)t * 1024 + ft * 256 + ch * 8;
            const u32x4 d = *(const u32x4*)(lds + row * EROW + ch * 16);
            float4 v0 = *(const float4*)(xin + off), v1 = *(const float4*)(xin + off + 4);
            v0.x += __uint_as_float(d.x << 16); v0.y += __uint_as_float(d.x & 0xffff0000u);
            v0.z += __uint_as_float(d.y << 16); v0.w += __uint_as_float(d.y & 0xffff0000u);
            v1.x += __uint_as_float(d.z << 16); v1.y += __uint_as_float(d.z & 0xffff0000u);
            v1.z += __uint_as_float(d.w << 16); v1.w += __uint_as_float(d.w & 0xffff0000u);
            __builtin_nontemporal_store(__builtin_bit_cast(u32x4, v0), (u32x4*)(p.out + off));
            __builtin_nontemporal_store(__builtin_bit_cast(u32x4, v1), (u32x4*)(p.out + off + 4));
            u32x4 xb4;
            xb4.x = pack2(v0.x, v0.y); xb4.y = pack2(v0.z, v0.w); xb4.z = pack2(v1.x, v1.y); xb4.w = pack2(v1.z, v1.w);
            *(u32x4*)((u16*)(ws + OFF_H) + off) = xb4;
            float ss = v0.x * v0.x + v0.y * v0.y + v0.z * v0.z + v0.w * v0.w + v1.x * v1.x + v1.y * v1.y + v1.z * v1.z + v1.w * v1.w;
#pragma unroll
            for (int o = 16; o >= 1; o >>= 1) ss += __shfl_xor(ss, o);
            if (ch == 0) ssacc[(size_t)ft * T_TOK + t] = ss;
          }
        }
      }
    } else if (sub == 6) {
      for (int w = blockIdx.x; w < 2048; w += G) {
        int tt, ft; tile_map(w, 16, 16, 4, tt, ft);
        f32x16 acc[8]; zero4(acc); zero4(acc + 4);
        gemm_main<4, 2>((const u16*)(ws + OFF_WFF1) + (size_t)ft * 256 * 1024, 1024, (const u16*)(ws + OFF_H) + (size_t)tt * 256 * 1024, 1024, 16, acc, lds);
        __syncthreads();
        float r2[2];
#pragma unroll
        for (int tb = 0; tb < 2; ++tb) r2[tb] = rstd4((const float*)(ws + OFF_SSX2), tt * 256 + wt * 64 + tb * 32 + l32);
#pragma unroll
        for (int tb = 0; tb < 2; ++tb)
#pragma unroll
          for (int fb = 0; fb < 4; ++fb)
#pragma unroll
            for (int jq = 0; jq < 4; ++jq) {
              const f32x16& a = acc[tb * 4 + fb];
              const float a0 = fmaxf(a[4 * jq], 0.f) * r2[tb], a1 = fmaxf(a[4 * jq + 1], 0.f) * r2[tb], a2 = fmaxf(a[4 * jq + 2], 0.f) * r2[tb], a3 = fmaxf(a[4 * jq + 3], 0.f) * r2[tb];
              epi_put4(lds, wt * 64 + tb * 32 + l32, wf * 128 + fb * 32 + 8 * jq + 4 * hh, a0 * a0, a1 * a1, a2 * a2, a3 * a3);
            }
        {
          const int r0 = tid >> 5, ch = tid & 31;
          u16* ub = (u16*)(ws + R_U) + ((size_t)(tt * 64 + ft * 4 + (ch >> 3)) * 256) * 64 + (ch & 7) * 8;
          __syncthreads();
#pragma unroll 4
          for (int r = r0; r < 256; r += 16) __builtin_nontemporal_store(*(const u32x4*)(lds + r * EROW + ch * 16), (u32x4*)(ub + (size_t)r * 64));
        }
      }
    }
    {
      int cv_l = 0, cv_lo = 0, cv_n = 0, cv_mem = 0;
      if (sub == 0) { cv_l = 0; cv_lo = 0; cv_n = NCONV / 2; cv_mem = 256; }
      else if (sub == 7 && l < 3) { cv_l = l + 1; cv_lo = 0; cv_n = 1764; cv_mem = 256; }
      else if (sub == 1 && l > 0) { cv_l = l; cv_lo = 1764; cv_n = 512; }
      for (int w2 = blockIdx.x; w2 < cv_n + cv_mem; w2 += G) {
        if (w2 < cv_n) conv_item(p, cv_l, cv_lo + w2, lds);
        else norm_rows8(p.mem, p.g_mem + cv_l * 1024, (u16*)(ws + OFF_HM), w2 - cv_n);
      }
    }
  }
}

extern "C" void kernel_launch(void* const* d_in, const int* in_sizes, int n_in, void* d_out, int out_size, void* d_ws, size_t ws_size,
                              hipStream_t stream) {
  static int grid_blocks = 0;
  if (grid_blocks == 0) {
    if (n_in != 28 || ws_size < WS_END) { fprintf(stderr, "kernel_launch: bad config n_in=%d ws=%zu need=%zu\n", n_in, ws_size, (size_t)WS_END); grid_blocks = -1; return; }
    int dev = 0, cus = 0, per_cu = 0;
    (void)hipGetDevice(&dev);
    (void)hipDeviceGetAttribute(&cus, hipDeviceAttributeMultiprocessorCount, dev);
    (void)hipFuncSetAttribute((const void*)mega, hipFuncAttributeMaxDynamicSharedMemorySize, LDS_BYTES);
    (void)hipOccupancyMaxActiveBlocksPerMultiprocessor(&per_cu, (const void*)mega, NT, LDS_BYTES);
    if (per_cu < 1) fprintf(stderr, "kernel_launch: occupancy query says %d blocks/CU\n", per_cu);
    grid_blocks = cus;
    (void)hipGetLastError();
  }
  if (grid_blocks < 0) return;
  Params p{};
  p.x = (const float*)d_in[0]; p.mem = (const float*)d_in[1]; p.pos = (const int*)d_in[2]; p.t5 = (const float*)d_in[3];
  p.g_mix = (const float*)d_in[4]; p.g_mem = (const float*)d_in[5]; p.w_in = (const float*)d_in[6]; p.g_cq = (const float*)d_in[7];
  p.w_uq = (const float*)d_in[8]; p.g_ckv = (const float*)d_in[9]; p.w_ukv = (const float*)d_in[10]; p.g_mla_q = (const float*)d_in[11];
  p.g_mla_k = (const float*)d_in[12]; p.g_diff_q = (const float*)d_in[13]; p.g_diff_k = (const float*)d_in[14];
  p.lam_q1 = (const float*)d_in[15]; p.lam_k1 = (const float*)d_in[16]; p.lam_q2 = (const float*)d_in[17]; p.lam_k2 = (const float*)d_in[18];
  p.g_diff_out = (const float*)d_in[19]; p.w_mem_kv = (const float*)d_in[20]; p.g_mem_q = (const float*)d_in[21]; p.g_mem_k = (const float*)d_in[22];
  p.w_branch = (const float*)d_in[23]; p.w_out = (const float*)d_in[24]; p.g_mlp = (const float*)d_in[25]; p.w_ff1 = (const float*)d_in[26];
  p.w_ff2 = (const float*)d_in[27];
  p.out = (float*)d_out; p.ws = (char*)d_ws;
  const int nph = 4 * NSUB;
#if SINGLE_LAUNCH
  p.ph_lo = 0; p.ph_hi = nph;
  { void* args[] = {&p};
    hipError_t e = hipLaunchCooperativeKernel((const void*)mega, dim3(grid_blocks), dim3(NT), args, LDS_BYTES, stream);
    if (e != hipSuccess) fprintf(stderr, "cooperative launch failed: %s (grid %d)\n", hipGetErrorString(e), grid_blocks); }
#else
  for (int ph = 0; ph < nph; ++ph) {
    p.ph_lo = ph; p.ph_hi = ph + 1;
    void* args[] = {&p};
    hipError_t e = hipLaunchCooperativeKernel((const void*)mega, dim3(grid_blocks), dim3(NT), args, LDS_BYTES, stream);
    if (e != hipSuccess) { fprintf(stderr, "cooperative launch failed: %s (grid %d)\n", hipGetErrorString(e), grid_blocks); break; }
    if (DUP_SUB >= 0 && (ph % NSUB) == DUP_SUB) {
      p.flags = 1;
      (void)hipLaunchCooperativeKernel((const void*)mega, dim3(grid_blocks), dim3(NT), args, LDS_BYTES, stream);
      p.flags = 0;
    }
  }
#endif
}
```
